# Optimizing an MI355X kernel written in HIP

```python
import jax, jax.numpy as jnp
from jax import lax
import numpy as np


D_MODEL = 1024
BATCH = 4
SEQ = 8192
DEPTH = 4
DEC_BATCH = 2
DEC_SEQ = 16384
PAST_LEN = 128

N_MEM = 256
XA_HEADS = 4
XA_HEAD_DIM = 128
XA_WIDTH = XA_HEADS * XA_HEAD_DIM
CHUNK = 128
SGU_WIDTH = 1536
SGU_GROUPS = 8
SGU_GROUP_DIM = SGU_WIDTH // SGU_GROUPS
MLA_HEADS = 8
Q_LORA = 256
KV_LORA = 128
QK_NOPE = 128
QK_ROPE = 64
V_HEAD = 128
ROPE_THETA = 10000.0
Q_BLOCK = 128
D_FF = 2816
N_SGU_LAYERS = (DEPTH + 1) // 2
N_MLA_LAYERS = DEPTH // 2
NORM_EPS = 1e-6

kernel_name = 'hybrid_sgu_mla_macaron_encoder'


def rms_norm(x, g):
    xf = x.astype(jnp.float32)
    y = xf * lax.rsqrt(jnp.mean(xf * xf, axis=-1, keepdims=True) + NORM_EPS)
    return (y * g.astype(jnp.float32)).astype(x.dtype)


def swiglu(h, w_in, w_out):
    gu = h @ w_in
    g, u = gu[..., :D_FF], gu[..., D_FF:]
    return (jax.nn.silu(g) * u) @ w_out


def rope_tables(seq_len):
    inv_freq = 1.0 / (ROPE_THETA ** (jnp.arange(0, QK_ROPE, 2, dtype=jnp.float32) / QK_ROPE))
    ang = jnp.arange(seq_len, dtype=jnp.float32)[:, None] * inv_freq[None, :]
    return jnp.cos(ang), jnp.sin(ang)


def apply_rope(x, cos, sin):
    half = x.shape[-1] // 2
    x1, x2 = x[..., :half], x[..., half:]
    c = cos.astype(x.dtype)
    s = sin.astype(x.dtype)
    return jnp.concatenate([x1 * c - x2 * s, x1 * s + x2 * c], axis=-1)


def memory_kv(mem, g, w):
    b, m, _ = mem.shape
    kv = rms_norm(mem, g) @ w
    k, v = kv[..., :XA_WIDTH], kv[..., XA_WIDTH:]
    return (k.reshape(b, m, XA_HEADS, XA_HEAD_DIM), v.reshape(b, m, XA_HEADS, XA_HEAD_DIM))


def memory_attention(q, mem_k, mem_v):
    b, s, _ = q.shape
    q = q.reshape(b, s, XA_HEADS, XA_HEAD_DIM) * (XA_HEAD_DIM ** -0.5)
    sc = jnp.einsum('bshd,bmhd->bhsm', q, mem_k, preferred_element_type=jnp.float32)
    p = jax.nn.softmax(sc, axis=-1).astype(mem_v.dtype)
    o = jnp.einsum('bhsm,bmhd->bshd', p, mem_v)
    return o.reshape(b, s, XA_WIDTH)


def sgu_mixer(h, mem_k, mem_v, w_in, v_norm, w_s, b_s, w_out):
    b, s, _ = h.shape
    proj = h @ w_in
    uv = jax.nn.gelu(proj[..., :2 * SGU_WIDTH])
    u, v = uv[..., :SGU_WIDTH], uv[..., SGU_WIDTH:]
    v = rms_norm(v, v_norm).reshape(b, s // CHUNK, CHUNK, SGU_GROUPS, SGU_GROUP_DIM)
    mixed = jnp.einsum('gpq,bnqgc->bnpgc', w_s, v) + b_s.T[None, None, :, :, None]
    gated = u * mixed.reshape(b, s, SGU_WIDTH)
    xa = memory_attention(proj[..., 2 * SGU_WIDTH:], mem_k, mem_v)
    return jnp.concatenate([gated, xa], axis=-1) @ w_out


def mla_mixer(h, mem_k, mem_v, cos, sin, w_in, q_norm, w_uq, kv_norm, w_uk, w_uv, w_out):
    b, s, _ = h.shape
    o1 = Q_LORA
    o2 = o1 + KV_LORA
    o3 = o2 + QK_ROPE
    proj = h @ w_in
    c_q = rms_norm(proj[..., :o1], q_norm)
    c_kv = rms_norm(proj[..., o1:o2], kv_norm)
    k_rope = apply_rope(proj[..., o2:o3], cos, sin)
    q = (c_q @ w_uq).reshape(b, s, MLA_HEADS, QK_NOPE + QK_ROPE)
    q_rope = apply_rope(q[..., QK_NOPE:], cos[:, None, :], sin[:, None, :])
    q_lat = jnp.einsum('bshn,chn->bshc', q[..., :QK_NOPE], w_uk)
    q_full = jnp.concatenate([q_lat, q_rope], axis=-1) * ((QK_NOPE + QK_ROPE) ** -0.5)
    k_full = jnp.concatenate([c_kv, k_rope], axis=-1)
    dk = KV_LORA + QK_ROPE
    q_blocks = q_full.reshape(b, s // Q_BLOCK, Q_BLOCK, MLA_HEADS, dk).transpose(1, 0, 2, 3, 4)

    def attend(qb):
        sc = jnp.einsum('bqhd,bkd->bhqk', qb, k_full, preferred_element_type=jnp.float32)
        p = jax.nn.softmax(sc, axis=-1).astype(c_kv.dtype)
        return jnp.einsum('bhqk,bkc->bqhc', p, c_kv)

    o_lat = lax.map(attend, q_blocks).transpose(1, 0, 2, 3, 4).reshape(b, s, MLA_HEADS, KV_LORA)
    o = jnp.einsum('bshc,chv->bshv', o_lat, w_uv).reshape(b, s, MLA_HEADS * V_HEAD)
    xa = memory_attention(proj[..., o3:], mem_k, mem_v)
    return jnp.concatenate([o, xa], axis=-1) @ w_out


def trunk(x, mem, p):
    cos, sin = rope_tables(x.shape[1])
    for i in range(DEPTH):
        j = i // 2
        x = x + 0.5 * swiglu(rms_norm(x, p['ffn1_norm'][i]), p['ffn1_w_in'][i], p['ffn1_w_out'][i])
        mem_k, mem_v = memory_kv(mem, p['mem_norm'][i], p['w_mem_kv'][i])
        h = rms_norm(x, p['mix_norm'][i])
        if i % 2 == 0:
            x = x + sgu_mixer(h, mem_k, mem_v, p['sgu_w_in'][j], p['sgu_v_norm'][j],
                              p['sgu_w_s'][j], p['sgu_b_s'][j], p['sgu_w_out'][j])
        else:
            x = x + mla_mixer(h, mem_k, mem_v, cos, sin, p['mla_w_in'][j], p['mla_q_norm'][j],
                              p['mla_w_uq'][j], p['mla_kv_norm'][j], p['mla_w_uk'][j],
                              p['mla_w_uv'][j], p['mla_w_out'][j])
        x = x + 0.5 * swiglu(rms_norm(x, p['ffn2_norm'][i]), p['ffn2_w_in'][i], p['ffn2_w_out'][i])
    return rms_norm(x, p['final_norm'])


def setup_inputs(seed: int = 0) -> dict:
    key = jax.random.key(seed)
    ks = jax.random.split(key, 32)

    def nrm(k, shape, scale):
        return jax.random.normal(k, shape, jnp.float32) * scale

    def gain(k, shape):
        return 1.0 + 0.02 * jax.random.normal(k, shape, jnp.float32)

    sgu_in = 2 * SGU_WIDTH + XA_WIDTH
    mla_in = Q_LORA + KV_LORA + QK_ROPE + XA_WIDTH
    return {
        'x_prompt': nrm(ks[0], (BATCH, SEQ, D_MODEL), 1.0),
        'x_sample': nrm(ks[1], (DEC_BATCH, DEC_SEQ, D_MODEL), 1.0),
        'mem_prompt': nrm(ks[2], (BATCH, N_MEM, D_MODEL), 1.0),
        'mem_sample': nrm(ks[3], (DEC_BATCH, N_MEM, D_MODEL), 1.0),
        'ffn1_norm': gain(ks[4], (DEPTH, D_MODEL)),
        'ffn1_w_in': nrm(ks[5], (DEPTH, D_MODEL, 2 * D_FF), D_MODEL ** -0.5),
        'ffn1_w_out': nrm(ks[6], (DEPTH, D_FF, D_MODEL), D_FF ** -0.5),
        'mix_norm': gain(ks[7], (DEPTH, D_MODEL)),
        'mem_norm': gain(ks[8], (DEPTH, D_MODEL)),
        'w_mem_kv': nrm(ks[9], (DEPTH, D_MODEL, 2 * XA_WIDTH), D_MODEL ** -0.5),
        'ffn2_norm': gain(ks[10], (DEPTH, D_MODEL)),
        'ffn2_w_in': nrm(ks[11], (DEPTH, D_MODEL, 2 * D_FF), D_MODEL ** -0.5),
        'ffn2_w_out': nrm(ks[12], (DEPTH, D_FF, D_MODEL), D_FF ** -0.5),
        'sgu_w_in': nrm(ks[13], (N_SGU_LAYERS, D_MODEL, sgu_in), D_MODEL ** -0.5),
        'sgu_v_norm': gain(ks[14], (N_SGU_LAYERS, SGU_WIDTH)),
        'sgu_w_s': nrm(ks[15], (N_SGU_LAYERS, SGU_GROUPS, CHUNK, CHUNK), 0.5 * CHUNK ** -0.5),
        'sgu_b_s': 1.0 + nrm(ks[16], (N_SGU_LAYERS, SGU_GROUPS, CHUNK), 0.02),
        'sgu_w_out': nrm(ks[17], (N_SGU_LAYERS, SGU_WIDTH + XA_WIDTH, D_MODEL), (SGU_WIDTH + XA_WIDTH) ** -0.5),
        'mla_w_in': nrm(ks[18], (N_MLA_LAYERS, D_MODEL, mla_in), D_MODEL ** -0.5),
        'mla_q_norm': gain(ks[19], (N_MLA_LAYERS, Q_LORA)),
        'mla_w_uq': nrm(ks[20], (N_MLA_LAYERS, Q_LORA, MLA_HEADS * (QK_NOPE + QK_ROPE)), Q_LORA ** -0.5),
        'mla_kv_norm': gain(ks[21], (N_MLA_LAYERS, KV_LORA)),
        'mla_w_uk': nrm(ks[22], (N_MLA_LAYERS, KV_LORA, MLA_HEADS, QK_NOPE), KV_LORA ** -0.5),
        'mla_w_uv': nrm(ks[23], (N_MLA_LAYERS, KV_LORA, MLA_HEADS, V_HEAD), KV_LORA ** -0.5),
        'mla_w_out': nrm(ks[24], (N_MLA_LAYERS, MLA_HEADS * V_HEAD + XA_WIDTH, D_MODEL), (MLA_HEADS * V_HEAD + XA_WIDTH) ** -0.5),
        'final_norm': gain(ks[25], (D_MODEL,)),
    }


def reference(x_prompt, x_sample, mem_prompt, mem_sample, ffn1_norm, ffn1_w_in, ffn1_w_out,
              mix_norm, mem_norm, w_mem_kv, ffn2_norm, ffn2_w_in, ffn2_w_out,
              sgu_w_in, sgu_v_norm, sgu_w_s, sgu_b_s, sgu_w_out,
              mla_w_in, mla_q_norm, mla_w_uq, mla_kv_norm, mla_w_uk, mla_w_uv, mla_w_out,
              final_norm):
    p = {
        'ffn1_norm': ffn1_norm, 'ffn1_w_in': ffn1_w_in, 'ffn1_w_out': ffn1_w_out,
        'mix_norm': mix_norm, 'mem_norm': mem_norm, 'w_mem_kv': w_mem_kv,
        'ffn2_norm': ffn2_norm, 'ffn2_w_in': ffn2_w_in, 'ffn2_w_out': ffn2_w_out,
        'sgu_w_in': sgu_w_in, 'sgu_v_norm': sgu_v_norm, 'sgu_w_s': sgu_w_s,
        'sgu_b_s': sgu_b_s, 'sgu_w_out': sgu_w_out,
        'mla_w_in': mla_w_in, 'mla_q_norm': mla_q_norm, 'mla_w_uq': mla_w_uq,
        'mla_kv_norm': mla_kv_norm, 'mla_w_uk': mla_w_uk, 'mla_w_uv': mla_w_uv,
        'mla_w_out': mla_w_out, 'final_norm': final_norm,
    }
    y_prompt = trunk(x_prompt, mem_prompt, p)
    y_sample = trunk(x_sample, mem_sample, p)
    return (y_prompt, y_sample)
```

```cpp
#include <hip/hip_runtime.h>
#include <hip/hip_cooperative_groups.h>
#include <cstdio>
#include <cstdint>
namespace cg = cooperative_groups;

#define LAS __attribute__((address_space(3)))
typedef unsigned short bf16_t;
typedef short bf16x8 __attribute__((ext_vector_type(8)));
typedef short s16x4 __attribute__((ext_vector_type(4)));
typedef float f32x4 __attribute__((ext_vector_type(4)));
typedef float f32x16 __attribute__((ext_vector_type(16)));
typedef unsigned u32x2 __attribute__((ext_vector_type(2)));
typedef unsigned u32x4 __attribute__((ext_vector_type(4)));

constexpr int NTOK = 65536, TPROMPT = 32768, DM = 1024, DFF = 2816;
constexpr int NCU = 256, NTHR = 512;
constexpr float EPS = 1e-6f;
#ifndef XLO
#define XLO 0
#endif
constexpr int XLD = 2048;
constexpr int HID_LD = 2816, P_LD = 2048, C2_LD = 2048, QF_LD = 1536, K_LD = 192;
constexpr int LDS_STAGE = 131072, LDS_TOTAL = 163840, LDS_ST = 131072, LDS_TAB = 159488;

constexpr size_t SZ_FFN_IN = (size_t)5632 * 1024 * 2, SZ_FFN_OUT = (size_t)1024 * 2816 * 2;
constexpr size_t SL_F1I = 0, SL_F1O = SL_F1I + SZ_FFN_IN, SL_F2I = SL_F1O + SZ_FFN_OUT, SL_F2O = SL_F2I + SZ_FFN_IN, SL_MIX = SL_F2O + SZ_FFN_OUT;
constexpr size_t SG_IN = SL_MIX, SG_OUT = SG_IN + (size_t)3584 * 1024 * 2, SG_WS = SG_OUT + (size_t)1024 * 2048 * 2, SLOTA_SZ = SG_WS + (size_t)8 * 128 * 128 * 2;
constexpr size_t ML_IN = SL_MIX, ML_Q = ML_IN + (size_t)1024 * 1024 * 2, ML_OUT = ML_Q + (size_t)1536 * 256 * 2, SLOTB_SZ = ML_OUT + (size_t)1024 * 1536 * 2;
constexpr size_t WS_SLOTA = 0, WS_SLOTB = WS_SLOTA + SLOTA_SZ;
constexpr size_t WS_MEMW = WS_SLOTB + SLOTB_SZ;
constexpr size_t WS_MEMN = WS_MEMW + (size_t)4 * 1024 * 1024 * 2;
constexpr size_t WS_MEMKV = WS_MEMN + (size_t)1536 * 1024 * 2;
constexpr size_t WS_ROPE = WS_MEMKV + (size_t)4 * 1536 * 1024 * 2;
constexpr size_t WS_KBUF = WS_ROPE + (size_t)2 * 16384 * 32 * 4;
constexpr size_t WS_SCR = WS_KBUF + (size_t)NTOK * K_LD * 2;
constexpr size_t SLAB = (size_t)256 * P_LD * 2 + (size_t)2 * 1536 * 128 * 2;
constexpr size_t SCR_HID = 0;
constexpr size_t SCR_P = 0, SCR_VT = (size_t)256 * P_LD * 2;
constexpr size_t SCR_QF = 0, SCR_C2 = (size_t)256 * QF_LD * 2;
static_assert(SCR_C2 + (size_t)256 * C2_LD * 2 <= SLAB && (size_t)256 * HID_LD * 2 <= SLAB, "slab too small");
constexpr size_t SCR_SZ = SLAB * NCU;
constexpr size_t WS_BAR = WS_SCR + SCR_SZ;
constexpr size_t WS_END = WS_BAR + 256;

struct Params { const float* in[26]; float* out; unsigned char* ws; };

#define GAS __attribute__((address_space(1)))
template <class T> __device__ __forceinline__ T gld(const void* p) { return *(const GAS T*)p; }
template <class T> __device__ __forceinline__ void gst(void* p, T v) { *(GAS T*)p = v; }
template <class T> __device__ __forceinline__ T* as_global(T* p) { return (T*)(__attribute__((address_space(1))) T*)p; }
__device__ __forceinline__ unsigned cvtpk(float lo, float hi) { unsigned r; asm volatile("v_cvt_pk_bf16_f32 %0, %1, %2" : "=v"(r) : "v"(lo), "v"(hi)); return r; }
__device__ __forceinline__ float bflo(unsigned w) { return __uint_as_float(w << 16); }
__device__ __forceinline__ float bfhi(unsigned w) { return __uint_as_float(w & 0xffff0000u); }
__device__ __forceinline__ bf16_t f2bf(float f) { return (bf16_t)(cvtpk(f, f) & 0xffffu); }
__device__ __forceinline__ float silu_f(float g) { return g * __builtin_amdgcn_rcpf(1.f + __expf(-g)); }
__device__ __forceinline__ float gelu_f(float x) { const float z = 1.5957691216057308f * (x + 0.044715f * x * x * x); return x * __builtin_amdgcn_rcpf(1.f + __expf(-z)); }
__device__ __forceinline__ f32x4 gelu4(f32x4 a, float r) {
    const f32x4 v = a * r, q = v * v; f32x4 e = v * (q * -0.10294324f + -2.30220819f);
    e[0] = __builtin_amdgcn_exp2f(e[0]); e[1] = __builtin_amdgcn_exp2f(e[1]); e[2] = __builtin_amdgcn_exp2f(e[2]); e[3] = __builtin_amdgcn_exp2f(e[3]);
    f32x4 d = e + 1.0f;
    d[0] = __builtin_amdgcn_rcpf(d[0]); d[1] = __builtin_amdgcn_rcpf(d[1]); d[2] = __builtin_amdgcn_rcpf(d[2]); d[3] = __builtin_amdgcn_rcpf(d[3]);
    return v * d;
}
__device__ __forceinline__ float wave_sum(float v) {
#pragma unroll
    for (int o = 32; o > 0; o >>= 1) v += __shfl_xor(v, o, 64);
    return v;
}

constexpr int BK = 64, HALF = 128, HTB = HALF * BK * 2;
#ifndef SNAKE
#define SNAKE 1
#endif
__device__ __forceinline__ int lds_byte(int r, int c) { const int st = (r >> 4) * 2 + (c >> 5), rr = r & 15, cc = c & 31, ob = rr * 64 + cc * 2; return st * 1024 + (ob ^ (((ob >> 9) & 1) << 5)); }
__device__ __forceinline__ void stage_rc(int b, int& R, int& C) { const int st = b / 1024, sb = b % 1024, swz = sb ^ (((sb >> 9) & 1) << 5); R = (st >> 1) * 16 + swz / 64; C = (st & 1) * 32 + (swz % 64) / 2; }

struct GemmArgs { const bf16_t* A; size_t hstepA; int lda; const bf16_t* Bt; int K; int nN; };
typedef f32x4 Acc[2][2][4][2];

enum { EP_FFN1 = 0, EP_XUPD, EP_SGU_IN, EP_MLA_IN, EP_MLA_Q, EP_MEMKV };
struct Epi {
    int mode; int cu; float alpha; unsigned char* ws; float* out; float* st;

    __device__ __forceinline__ size_t grow(int ai, int rr) const { return (size_t)ai * TPROMPT + (size_t)cu * 128 + rr; }
    __device__ __forceinline__ size_t lrow(int ai, int rr) const { return (size_t)(ai * 128 + rr); }

    __device__ __forceinline__ void operator()(Acc& acc, int pn, int wr, int wc, int fr, int fq) const {
        asm volatile("" : "+v"(fr), "+v"(fq));
        unsigned char* const slab = ws + WS_SCR + (size_t)cu * SLAB;
        float* const st_rsx_ = st, *const st_rq_ = st + 512, *const st_xacc_ = st + 1024 + wc * 256, *const st_vacc_ = st + 2048 + wc * 256, *const st_qacc_ = st + 3072 + wc * 256;
        if (mode == EP_FFN1) {
            bf16_t* const o0 = (bf16_t*)(slab + SCR_HID); constexpr int ld0 = HID_LD; const float* const st_r = st_rsx_;
#pragma unroll
            for (int ai = 0; ai < 2; ++ai)
#pragma unroll
                for (int m = 0; m < 4; ++m) {
                    const int rr = wr * 64 + m * 16 + fr; const float r = st_r[ai * 128 + rr];
                    bf16_t* rowp = o0 + lrow(ai, rr) * (size_t)ld0 + pn * 128 + wc * 32 + fq * 8;
                    u32x4 w; const float c1 = -1.4426950408889634f * r, r2 = r * r;
#pragma unroll
                    for (int n = 0; n < 2; ++n) {
                        const f32x4 g = acc[ai][0][m][n], u = acc[ai][1][m][n];
                        f32x4 e = g * c1;
                        e[0] = __builtin_amdgcn_exp2f(e[0]); e[1] = __builtin_amdgcn_exp2f(e[1]); e[2] = __builtin_amdgcn_exp2f(e[2]); e[3] = __builtin_amdgcn_exp2f(e[3]);
                        f32x4 d = e + 1.0f;
                        d[0] = __builtin_amdgcn_rcpf(d[0]); d[1] = __builtin_amdgcn_rcpf(d[1]); d[2] = __builtin_amdgcn_rcpf(d[2]); d[3] = __builtin_amdgcn_rcpf(d[3]);
                        const f32x4 h = (g * u) * (d * r2);
                        w[2 * n] = cvtpk(h[0], h[1]); w[2 * n + 1] = cvtpk(h[2], h[3]);
                    }
                    gst<u32x4>(rowp, w);
                }
        } else if (mode == EP_XUPD) {
            bf16_t* const x = (bf16_t*)out; float* const st_acc = st_xacc_;
#pragma unroll
            for (int ai = 0; ai < 2; ++ai)
#pragma unroll
                for (int m = 0; m < 4; ++m) {
                    const int rr = wr * 64 + m * 16 + fr;
                    bf16_t* rowp = x + grow(ai, rr) * (size_t)XLD + pn * 256 + wc * 32 + fq * 8;
                    float ss = 0.f;
#pragma unroll
                    for (int bj = 0; bj < 2; ++bj) {
                        bf16_t* p = rowp + bj * 128;
                        const u32x4 h = gld<u32x4>(p); u32x4 l = {0u, 0u, 0u, 0u}; if (XLO) l = gld<u32x4>(p + 1024);
                        u32x4 nh, nl;
#pragma unroll
                        for (int n = 0; n < 2; ++n) {
                            const f32x4 a = acc[ai][bj][m][n];
                            const float x0 = bflo(h[2 * n]) + bflo(l[2 * n]) + alpha * a[0], x1 = bfhi(h[2 * n]) + bfhi(l[2 * n]) + alpha * a[1];
                            const float x2 = bflo(h[2 * n + 1]) + bflo(l[2 * n + 1]) + alpha * a[2], x3 = bfhi(h[2 * n + 1]) + bfhi(l[2 * n + 1]) + alpha * a[3];
                            ss += x0 * x0 + x1 * x1 + x2 * x2 + x3 * x3;
                            nh[2 * n] = cvtpk(x0, x1); nh[2 * n + 1] = cvtpk(x2, x3);
                            if (XLO) { nl[2 * n] = cvtpk(x0 - bflo(nh[2 * n]), x1 - bfhi(nh[2 * n])); nl[2 * n + 1] = cvtpk(x2 - bflo(nh[2 * n + 1]), x3 - bfhi(nh[2 * n + 1])); }
                        }
                        gst<u32x4>(p, nh); if (XLO) gst<u32x4>(p + 1024, nl);
                    }
                    ss += __shfl_xor(ss, 16, 64); ss += __shfl_xor(ss, 32, 64);
                    if (fq == 0) st_acc[ai * 128 + rr] += ss;
                }
        } else if (mode == EP_SGU_IN) {
            bf16_t* const o0 = (bf16_t*)(slab + SCR_P); constexpr int ld0 = P_LD; const float* const st_r = st_rsx_; float* const st_acc = st_vacc_;
            bf16_t* const vt = (bf16_t*)(slab + SCR_VT);
            if (pn < 8) {
#pragma unroll
                for (int ai = 0; ai < 2; ++ai)
#pragma unroll
                    for (int m = 0; m < 4; ++m) {
                        const int rr = wr * 64 + m * 16 + fr; const float r = st_r[ai * 128 + rr];
                        bf16_t* rowp = o0 + lrow(ai, rr) * (size_t)ld0 + pn * 256 + wc * 32 + fq * 8;
#pragma unroll
                        for (int bj = 0; bj < 2; ++bj) {
                            u32x4 w;
#pragma unroll
                            for (int n = 0; n < 2; ++n) {
                                const f32x4 v = (pn < 6) ? gelu4(acc[ai][bj][m][n], r) : acc[ai][bj][m][n] * r;
                                w[2 * n] = cvtpk(v[0], v[1]); w[2 * n + 1] = cvtpk(v[2], v[3]);
                            }
                            gst<u32x4>(rowp + bj * 128, w);
                        }
                    }
            } else {
#pragma unroll
                for (int ai = 0; ai < 2; ++ai)
#pragma unroll
                    for (int m = 0; m < 4; ++m) {
                        const int rr = wr * 64 + m * 16 + fr; const float r = st_r[ai * 128 + rr];
                        bf16_t* colp = vt + ((size_t)ai * 1536 + (size_t)(pn - 8) * 256 + wc * 32 + fq * 8) * 128 + rr;
                        float ss = 0.f;
#pragma unroll
                        for (int bj = 0; bj < 2; ++bj)
#pragma unroll
                            for (int n = 0; n < 2; ++n) {
                                const f32x4 gv = gelu4(acc[ai][bj][m][n], r);
#pragma unroll
                                for (int i = 0; i < 4; ++i) { const float v = gv[i]; ss += v * v; gst<bf16_t>(colp + (size_t)(bj * 128 + n * 4 + i) * 128, f2bf(v)); }
                            }
                        ss += __shfl_xor(ss, 16, 64); ss += __shfl_xor(ss, 32, 64);
                        if (fq == 0) st_acc[ai * 128 + rr] += ss;
                    }
            }
        } else if (mode == EP_MLA_IN) {
            bf16_t* const c2 = (bf16_t*)(slab + SCR_C2); bf16_t* const o0 = c2; constexpr int ld0 = C2_LD, ldkv = C2_LD / 2; float* const kvraw = (float*)(c2 + 256);
            const float* const st_r = st_rsx_; float* const st_acc = st_qacc_;
            if (pn == 0) {
#pragma unroll
                for (int ai = 0; ai < 2; ++ai)
#pragma unroll
                    for (int m = 0; m < 4; ++m) {
                        const int rr = wr * 64 + m * 16 + fr; const float r = st_r[ai * 128 + rr];
                        bf16_t* rowp = o0 + lrow(ai, rr) * (size_t)ld0 + wc * 32 + fq * 8;
                        float ss = 0.f;
#pragma unroll
                        for (int bj = 0; bj < 2; ++bj)
#pragma unroll
                            for (int n = 0; n < 2; ++n) {
                                const f32x4 v = acc[ai][bj][m][n] * r;
                                ss += v[0] * v[0] + v[1] * v[1] + v[2] * v[2] + v[3] * v[3];
                                u32x2 w; w[0] = cvtpk(v[0], v[1]); w[1] = cvtpk(v[2], v[3]);
                                gst<u32x2>(rowp + bj * 128 + n * 4, w);
                            }
                        ss += __shfl_xor(ss, 16, 64); ss += __shfl_xor(ss, 32, 64);
                        if (fq == 0) st_acc[ai * 128 + rr] += ss;
                        __builtin_amdgcn_sched_barrier(0);
                    }
            } else if (pn == 1) {
#pragma unroll
                for (int ai = 0; ai < 2; ++ai)
#pragma unroll
                    for (int m = 0; m < 4; ++m) {
                        const int rr = wr * 64 + m * 16 + fr; const float r = st_r[ai * 128 + rr];
                        float* rowp = kvraw + lrow(ai, rr) * (size_t)ldkv + wc * 32 + fq * 8;
#pragma unroll
                        for (int n = 0; n < 2; ++n) {
                            gst<f32x4>(rowp + n * 4, acc[ai][0][m][n] * r);
                            if (wc < 2) gst<f32x4>(rowp + 128 + n * 4, acc[ai][1][m][n] * r);
                        }
                        __builtin_amdgcn_sched_barrier(0);
                    }
            } else {
#pragma unroll
                for (int ai = 0; ai < 2; ++ai)
#pragma unroll
                    for (int m = 0; m < 4; ++m) {
                        const int rr = wr * 64 + m * 16 + fr; const float r = st_r[ai * 128 + rr];
                        bf16_t* rowp = c2 + lrow(ai, rr) * (size_t)C2_LD + 1024 + (pn - 2) * 256 + wc * 32 + fq * 8;
#pragma unroll
                        for (int bj = 0; bj < 2; ++bj)
#pragma unroll
                            for (int n = 0; n < 2; ++n) {
                                const f32x4 v = acc[ai][bj][m][n] * r;
                                u32x2 w; w[0] = cvtpk(v[0], v[1]); w[1] = cvtpk(v[2], v[3]);
                                gst<u32x2>(rowp + bj * 128 + n * 4, w);
                            }
                        __builtin_amdgcn_sched_barrier(0);
                    }
            }
        } else if (mode == EP_MLA_Q) {
            bf16_t* const o0 = (bf16_t*)(slab + SCR_QF); constexpr int ld0 = QF_LD; const float* const st_r = st_rq_;
            const float* const rcos = (const float*)(ws + WS_ROPE); const float* const rsin = rcos + 16384 * 32;
            if (pn < 4) {
#pragma unroll
                for (int ai = 0; ai < 2; ++ai)
#pragma unroll
                    for (int m = 0; m < 4; ++m) {
                        const int rr = wr * 64 + m * 16 + fr; const float r = st_r[ai * 128 + rr];
                        bf16_t* rowp = o0 + lrow(ai, rr) * (size_t)ld0 + 2 * pn * 192 + wc * 32 + fq * 8;
#pragma unroll
                        for (int bj = 0; bj < 2; ++bj)
#pragma unroll
                            for (int n = 0; n < 2; ++n) {
                                const f32x4 v = acc[ai][bj][m][n] * r;
                                u32x2 w; w[0] = cvtpk(v[0], v[1]); w[1] = cvtpk(v[2], v[3]);
                                gst<u32x2>(rowp + bj * 192 + n * 4, w);
                            }
                        __builtin_amdgcn_sched_barrier(0);
                    }
            } else {
#pragma unroll
                for (int ai = 0; ai < 2; ++ai)
#pragma unroll
                    for (int m = 0; m < 4; ++m) {
                        const int rr = wr * 64 + m * 16 + fr; const float r = st_r[ai * 128 + rr];
                        const int pos = (cu * 128 + rr) & (ai ? 16383 : 8191);
                        bf16_t* rowp = o0 + lrow(ai, rr) * (size_t)ld0 + (4 * (pn - 4) + wc) * 192 + 128 + fq * 8;
                        const float* cp = rcos + pos * 32 + fq * 8; const float* sp = rsin + pos * 32 + fq * 8;
#pragma unroll
                        for (int n = 0; n < 2; ++n) {
                            const f32x4 c = gld<f32x4>(cp + n * 4), s = gld<f32x4>(sp + n * 4);
                            const f32x4 x1 = acc[ai][0][m][n] * r, x2 = acc[ai][1][m][n] * r;
                            const f32x4 y1 = x1 * c - x2 * s, y2 = x1 * s + x2 * c;
                            u32x2 w1, w2; w1[0] = cvtpk(y1[0], y1[1]); w1[1] = cvtpk(y1[2], y1[3]); w2[0] = cvtpk(y2[0], y2[1]); w2[1] = cvtpk(y2[2], y2[3]);
                            gst<u32x2>(rowp + n * 4, w1); gst<u32x2>(rowp + 32 + n * 4, w2);
                        }
                        __builtin_amdgcn_sched_barrier(0);
                    }
            }
        } else {
            const int pn0 = cu & 3; constexpr int ld0 = 1024;
            bf16_t* const o0 = (bf16_t*)(ws + WS_MEMKV) + ((size_t)(cu / 24) * 1536 + ((cu % 24) >> 2) * 256) * 1024;
#pragma unroll
            for (int ai = 0; ai < 2; ++ai)
#pragma unroll
                for (int m = 0; m < 4; ++m) {
                    bf16_t* rowp = o0 + (size_t)(ai * 128 + wr * 64 + m * 16 + fr) * ld0 + pn0 * 256 + wc * 32 + fq * 8;
#pragma unroll
                    for (int bj = 0; bj < 2; ++bj)
#pragma unroll
                        for (int n = 0; n < 2; ++n) {
                            const f32x4 v = acc[ai][bj][m][n];
                            u32x2 w; w[0] = cvtpk(v[0], v[1]); w[1] = cvtpk(v[2], v[3]);
                            gst<u32x2>(rowp + bj * 128 + n * 4, w);
                        }
                }
        }
    }
};

__device__ __forceinline__ void gemm_phase(LAS unsigned char* lds, const GemmArgs g, const Epi& E, const int tid) {
    const int wid = __builtin_amdgcn_readfirstlane(tid >> 6), lane = tid & 63, wr = wid >> 2, wc = wid & 3, fr = lane & 15, fq = lane >> 4;
    const int K = g.K, nt = K / BK;
    unsigned voffA[2], voffB[2];
#pragma unroll
    for (int i = 0; i < 2; ++i) { int R, C; stage_rc(tid * 16 + i * 8192, R, C); const int rho = R & 31, Rb = (R & ~31) + 8 * ((rho & 15) >> 2) + 4 * (rho >> 4) + (rho & 3);
        voffA[i] = (unsigned)(R * g.lda + C) * 2u; voffB[i] = (unsigned)(Rb * K + C) * 2u; }
    const size_t kstep = (size_t)(BK * 2);
    const size_t hstepB = (size_t)HALF * K * 2, tstepB = 2 * hstepB, hstepA = g.hstepA;
    const unsigned ldsw = (unsigned)wid * 1024u;
    const int aoff = lds_byte(wr * 64 + fr, fq * 8), boff = lds_byte(wc * 32 + fr, fq * 8);
#define PG8_SA(b, h) (((b) * 2 + (h)) * HTB)
#define PG8_SB(b, h) ((4 + (b) * 2 + (h)) * HTB)
#define PG8_STAGE(bufoff, gbase, voff) do { _Pragma("unroll") for (int _i = 0; _i < 2; ++_i) \
        __builtin_amdgcn_global_load_lds((const unsigned*)((const char*)(gbase) + (voff)[_i]), (LAS unsigned*)(lds + (bufoff) + ldsw + _i * 8192), 16, 0, 0); } while (0)
#define PG8_LDA(dst, b, h) do { _Pragma("unroll") for (int m = 0; m < 4; ++m) _Pragma("unroll") for (int k = 0; k < 2; ++k) dst[m][k] = *(const LAS bf16x8*)(lds + PG8_SA(b, h) + aoff + m * 2048 + k * 1024); } while (0)
#define PG8_LDB(dst, b, h) do { _Pragma("unroll") for (int n = 0; n < 2; ++n) _Pragma("unroll") for (int k = 0; k < 2; ++k) dst[n][k] = *(const LAS bf16x8*)(lds + PG8_SB(b, h) + boff + n * 2048 + k * 1024); } while (0)
#define PG8_MMA(ai, bj, At, Bt) do { __builtin_amdgcn_s_setprio(1); _Pragma("unroll") for (int m = 0; m < 4; ++m) _Pragma("unroll") for (int n = 0; n < 2; ++n) _Pragma("unroll") for (int k = 0; k < 2; ++k) \
        acc[ai][bj][m][n] = __builtin_amdgcn_mfma_f32_16x16x32_bf16(Bt[n][k], At[m][k], acc[ai][bj][m][n], 0, 0, 0); __builtin_amdgcn_s_setprio(0); } while (0)
#define PG8_WAIT_V(n) asm volatile("s_waitcnt vmcnt(" #n ")" ::: "memory")
#define PG8_WAIT_L(n) asm volatile("s_waitcnt lgkmcnt(" #n ")" ::: "memory")
#define PG8_BAR __builtin_amdgcn_s_barrier()
#define PG8_SCHED __builtin_amdgcn_sched_barrier(0)
    int ui = 0;
    Acc acc;
#pragma unroll
    for (int a = 0; a < 2; ++a)
#pragma unroll
        for (int b = 0; b < 2; ++b)
#pragma unroll
            for (int m = 0; m < 4; ++m)
#pragma unroll
                for (int n = 0; n < 2; ++n) acc[a][b][m][n] = (f32x4){0.f, 0.f, 0.f, 0.f};
    bf16x8 At[4][2], B0[2][2], B1[2][2];
    const ptrdiff_t KS = (ptrdiff_t)(BK * 2), lastoff = (ptrdiff_t)(nt - 1) * KS;
    const char* cA = (const char*)g.A; const char* cB = (const char*)g.Bt; ptrdiff_t ks = KS;
    PG8_STAGE(PG8_SB(0, 0), cB, voffB); PG8_STAGE(PG8_SA(0, 0), cA, voffA); PG8_STAGE(PG8_SB(0, 1), cB + hstepB, voffB); PG8_STAGE(PG8_SA(0, 1), cA + hstepA, voffA);
    if (wr == 1) PG8_BAR;
    PG8_WAIT_V(4); PG8_BAR;
    PG8_STAGE(PG8_SB(1, 0), cB + kstep, voffB); PG8_STAGE(PG8_SA(1, 0), cA + kstep, voffA); PG8_STAGE(PG8_SB(1, 1), cB + hstepB + kstep, voffB);
    PG8_WAIT_V(6); PG8_BAR;
    for (;;) {
        const bool has_next = (ui + 1 < g.nN);
        const bool nrev = SNAKE && (((ui + 1) & 1) != 0);
        const char* nA = has_next ? (const char*)g.A + (nrev ? lastoff : 0) : cA;
        const char* nB = has_next ? (const char*)g.Bt + (size_t)(ui + 1) * tstepB + (nrev ? lastoff : 0) : cB;
        const ptrdiff_t nks = has_next ? (nrev ? -KS : KS) : ks;
        for (int t = 0; t < nt; t += 2) {
            const bool last = (t == nt - 2);
            const char* a1 = cA + (ptrdiff_t)(t + 1) * ks;
            const char* a2 = last ? nA : cA + (ptrdiff_t)(t + 2) * ks; const char* b2 = last ? nB : cB + (ptrdiff_t)(t + 2) * ks;
            const ptrdiff_t k3 = last ? nks : ks;
            const char* a3 = a2 + k3; const char* b3 = b2 + k3;
            PG8_LDB(B0, 0, 0); PG8_SCHED; PG8_LDA(At, 0, 0); PG8_STAGE(PG8_SA(1, 1), a1 + hstepA, voffA);
            PG8_WAIT_L(8); PG8_BAR; PG8_WAIT_L(0); PG8_MMA(0, 0, At, B0); PG8_BAR; PG8_SCHED;
            PG8_LDB(B1, 0, 1); PG8_STAGE(PG8_SB(0, 0), b2, voffB);
            PG8_BAR; PG8_WAIT_L(0); PG8_MMA(0, 1, At, B1); PG8_BAR;
            PG8_LDA(At, 0, 1); PG8_STAGE(PG8_SA(0, 0), a2, voffA);
            PG8_BAR; PG8_WAIT_L(0); PG8_MMA(1, 0, At, B0); PG8_BAR; PG8_SCHED;
            PG8_STAGE(PG8_SB(0, 1), b2 + hstepB, voffB);
            PG8_WAIT_V(6); PG8_BAR; PG8_MMA(1, 1, At, B1); PG8_BAR;
            PG8_LDB(B0, 1, 0); PG8_SCHED; PG8_LDA(At, 1, 0); PG8_STAGE(PG8_SA(0, 1), a2 + hstepA, voffA);
            PG8_WAIT_L(8); PG8_BAR; PG8_WAIT_L(0); PG8_MMA(0, 0, At, B0); PG8_BAR; PG8_SCHED;
            PG8_LDB(B1, 1, 1); PG8_STAGE(PG8_SB(1, 0), b3, voffB);
            PG8_BAR; PG8_WAIT_L(0); PG8_MMA(0, 1, At, B1); PG8_BAR;
            PG8_LDA(At, 1, 1); PG8_STAGE(PG8_SA(1, 0), a3, voffA);
            PG8_BAR; PG8_WAIT_L(0); PG8_MMA(1, 0, At, B0); PG8_BAR; PG8_SCHED;
            PG8_STAGE(PG8_SB(1, 1), b3 + hstepB, voffB);
            PG8_WAIT_V(6); PG8_BAR; PG8_MMA(1, 1, At, B1); PG8_BAR;
        }
        E(acc, ui, wr, wc, fr, fq);
        if (!has_next) break;
#pragma unroll
        for (int a = 0; a < 2; ++a)
#pragma unroll
            for (int b = 0; b < 2; ++b)
#pragma unroll
                for (int m = 0; m < 4; ++m)
#pragma unroll
                    for (int n = 0; n < 2; ++n) acc[a][b][m][n] = (f32x4){0.f, 0.f, 0.f, 0.f};
        cA = nA; cB = nB; ks = nks; ++ui;
    }
    PG8_WAIT_V(0);
    if (wr == 0) PG8_BAR;
    PG8_BAR;
#undef PG8_SA
#undef PG8_SB
#undef PG8_STAGE
#undef PG8_LDA
#undef PG8_LDB
#undef PG8_MMA
#undef PG8_WAIT_V
#undef PG8_WAIT_L
#undef PG8_BAR
#undef PG8_SCHED
    __syncthreads();
}

#define KSWZ(row, colB) ((row) * 256 + ((colB) ^ (((row) & 15) << 4)))
#define KRSWZ(row, colB) ((row) * 128 + ((colB) ^ ((((row) >> 1) & 7) << 4)))
#define SBAR() __builtin_amdgcn_sched_barrier(0)
constexpr float ATT_THR = 8.f;
constexpr int SHM_V = 64 * 128 * 2, SHM_K = 64 * 128 * 2, SHM_KR = 64 * 64 * 2;
constexpr int AL_V = 0, AL_K = 2 * SHM_V, AL_KR = AL_K + 2 * SHM_K, AL_WS = AL_KR + 2 * SHM_KR, AL_Q = AL_WS + 2048;
#ifndef MLA_DMA
#define MLA_DMA 1
#endif
#ifndef MLA_NQL
#define MLA_NQL 4
#endif
#ifndef MLA_SD
#define MLA_SD 1
#endif
constexpr int NQL = MLA_NQL;
static_assert(AL_Q + 8 * NQL * 1024 <= LDS_TAB, "attention LDS overflows into the statistics");
__device__ __forceinline__ int crow(int r, int hi) { return (r & 3) + 8 * (r >> 2) + 4 * hi; }

template <bool MLA> __device__ __forceinline__ void partialSM(f32x16& p0, f32x16& p1, float& m_reg, float& mn, float& alpha) {
    constexpr float SCALE = MLA ? 1.0f : 0.088388347648318440f;
    constexpr float C = SCALE * 1.4426950408889634f;
    float pmax = p0[0];
#pragma unroll
    for (int r = 1; r < 16; ++r) pmax = fmaxf(pmax, p0[r]);
#pragma unroll
    for (int r = 0; r < 16; ++r) pmax = fmaxf(pmax, p1[r]);
    { auto rr = __builtin_amdgcn_permlane32_swap(__float_as_uint(pmax), __float_as_uint(pmax), false, false);
      pmax = fmaxf(__uint_as_float(rr[0]), __uint_as_float(rr[1])); }
    if (__builtin_expect(__all(pmax - m_reg <= ATT_THR / SCALE), 1)) { mn = m_reg; alpha = 1.f; }
    else { mn = fmaxf(m_reg, pmax); alpha = __builtin_amdgcn_exp2f((m_reg - mn) * C); m_reg = mn; }
    const float mnC = -mn * C;
#pragma unroll
    for (int r = 0; r < 16; ++r) p0[r] = fmaf(p0[r], C, mnC);
#pragma unroll
    for (int r = 0; r < 16; ++r) p1[r] = fmaf(p1[r], C, mnC);
#pragma unroll
    for (int r = 0; r < 16; ++r) p0[r] = __builtin_amdgcn_exp2f(p0[r]);
}
__device__ __forceinline__ void finishSM(f32x16& p0, f32x16& p1, float alpha, float& l_reg, bf16x8& pa0, bf16x8& pa1, bf16x8& pa2, bf16x8& pa3) {
#pragma unroll
    for (int r = 0; r < 16; ++r) p1[r] = __builtin_amdgcn_exp2f(p1[r]);
    float ps = 0;
#pragma unroll
    for (int r = 0; r < 16; ++r) ps += p0[r];
#pragma unroll
    for (int r = 0; r < 16; ++r) ps += p1[r];
    { auto rr = __builtin_amdgcn_permlane32_swap(__float_as_uint(ps), __float_as_uint(ps), false, false);
      ps = __uint_as_float(rr[0]) + __uint_as_float(rr[1]); }
    l_reg = l_reg * alpha + ps;
#define PK4(P, BASE, OUT) do { unsigned a0 = cvtpk(P[BASE + 0], P[BASE + 1]), a1 = cvtpk(P[BASE + 2], P[BASE + 3]);   \
    unsigned b0 = cvtpk(P[BASE + 4], P[BASE + 5]), b1 = cvtpk(P[BASE + 6], P[BASE + 7]);                              \
    auto r0 = __builtin_amdgcn_permlane32_swap(a0, b0, false, false); auto r1 = __builtin_amdgcn_permlane32_swap(a1, b1, false, false); \
    u32x4 w = {r0[0], r1[0], r0[1], r1[1]}; OUT = *reinterpret_cast<bf16x8*>(&w); } while (0)
    PK4(p0, 0, pa0); PK4(p0, 8, pa1); PK4(p1, 0, pa2); PK4(p1, 8, pa3);
#undef PK4
}
template <bool MLA> __device__ __forceinline__ void qkt(f32x16& p0, f32x16& p1, const char* Ks, const char* KRs, const bf16x8* qr, const char* ql, int r32, int hi) {
    p0 = f32x16{}; p1 = f32x16{};
#pragma unroll
    for (int d0 = 0; d0 < 8; ++d0) { const int cb = (d0 * 16 + hi * 8) * 2;
        const bf16x8 b0 = *reinterpret_cast<const bf16x8*>(Ks + KSWZ(r32, cb));
        const bf16x8 b1 = *reinterpret_cast<const bf16x8*>(Ks + KSWZ(32 + r32, cb));
        const bf16x8 qq = (MLA && d0 >= 12 - NQL) ? *reinterpret_cast<const bf16x8*>(ql + (d0 - (12 - NQL)) * 1024) : qr[(MLA && d0 >= 12 - NQL) ? 0 : d0];
        p0 = __builtin_amdgcn_mfma_f32_32x32x16_bf16(b0, qq, p0, 0, 0, 0);
        p1 = __builtin_amdgcn_mfma_f32_32x32x16_bf16(b1, qq, p1, 0, 0, 0); }
    if constexpr (MLA) {
#pragma unroll
        for (int d0 = 0; d0 < 4; ++d0) { const int cb = (d0 * 16 + hi * 8) * 2;
            const bf16x8 b0 = *reinterpret_cast<const bf16x8*>(KRs + KRSWZ(r32, cb));
            const bf16x8 b1 = *reinterpret_cast<const bf16x8*>(KRs + KRSWZ(32 + r32, cb));
            const bf16x8 qq = (8 + d0 >= 12 - NQL) ? *reinterpret_cast<const bf16x8*>(ql + (8 + d0 - (12 - NQL)) * 1024) : qr[(8 + d0 >= 12 - NQL) ? 0 : 8 + d0];
            p0 = __builtin_amdgcn_mfma_f32_32x32x16_bf16(b0, qq, p0, 0, 0, 0);
            p1 = __builtin_amdgcn_mfma_f32_32x32x16_bf16(b1, qq, p1, 0, 0, 0); }
    }
}
__device__ __forceinline__ int v_st(int k, int c) { const int kk = (k & ~0xC) | ((k & 4) << 1) | ((k & 8) >> 1); return ((kk >> 3) * 4 + (c >> 5)) * 512 + ((kk & 7) * 32 + (c & 31)) * 2; }
__device__ __forceinline__ int v_rd_base(int lane) { return ((lane & 3) << 3) | (((lane >> 2) & 3) << 6) | (((lane >> 4) & 1) << 5) | (((lane >> 5) & 1) << 8); }
constexpr int v_rd_off(int d0, int ks, int half) { return d0 * 512 + ks * 4096 + half * 2048; }
template <int OFF> __device__ __forceinline__ s16x4 tr_read(int vb) {
    s16x4 r; asm volatile("ds_read_b64_tr_b16 %0, %1 offset:%2" : "=&v"(r) : "v"(vb), "i"(OFF) : "memory"); return r;
}
template <int D0> __device__ __forceinline__ void pv_one(f32x16& od, int vb, bf16x8 pa0, bf16x8 pa1, bf16x8 pa2, bf16x8 pa3) {
    const s16x4 l0 = tr_read<v_rd_off(D0, 0, 0)>(vb), h0 = tr_read<v_rd_off(D0, 0, 1)>(vb), l1 = tr_read<v_rd_off(D0, 1, 0)>(vb), h1 = tr_read<v_rd_off(D0, 1, 1)>(vb);
    const s16x4 l2 = tr_read<v_rd_off(D0, 2, 0)>(vb), h2 = tr_read<v_rd_off(D0, 2, 1)>(vb), l3 = tr_read<v_rd_off(D0, 3, 0)>(vb), h3 = tr_read<v_rd_off(D0, 3, 1)>(vb);
    asm volatile("s_waitcnt lgkmcnt(0)" ::: "memory"); SBAR();
#define PK(L, H) (bf16x8){L[0], L[1], L[2], L[3], H[0], H[1], H[2], H[3]}
    od = __builtin_amdgcn_mfma_f32_32x32x16_bf16(pa0, PK(l0, h0), od, 0, 0, 0);
    od = __builtin_amdgcn_mfma_f32_32x32x16_bf16(pa1, PK(l1, h1), od, 0, 0, 0);
    od = __builtin_amdgcn_mfma_f32_32x32x16_bf16(pa2, PK(l2, h2), od, 0, 0, 0);
    od = __builtin_amdgcn_mfma_f32_32x32x16_bf16(pa3, PK(l3, h3), od, 0, 0, 0);
#undef PK
}
__device__ __forceinline__ void pv_d0(f32x16* o, int vb, bf16x8 pa0, bf16x8 pa1, bf16x8 pa2, bf16x8 pa3) {
    pv_one<0>(o[0], vb, pa0, pa1, pa2, pa3); pv_one<1>(o[1], vb, pa0, pa1, pa2, pa3); pv_one<2>(o[2], vb, pa0, pa1, pa2, pa3); pv_one<3>(o[3], vb, pa0, pa1, pa2, pa3);
}

template <bool MLA, int ldq, int ldk, int ldo>
__device__ __forceinline__ void attn_body(const bf16_t* __restrict__ Qw, const bf16_t* __restrict__ Kg, const bf16_t* __restrict__ Vg, int seq,
                                          bf16_t* __restrict__ Ow, bool do_store, char* lds, const int tid) {
    constexpr int NQ = MLA ? 12 - NQL : 8;
    const int wid = tid >> 6, lane = tid & 63, r32 = lane & 31, hi = lane >> 5;
    char* V_lds = lds + AL_V; char* K_lds = lds + AL_K; char* KR_lds = lds + AL_KR;
    float* ws = (float*)(lds + AL_WS) + wid * 64; float* li_l = ws; float* al_l = ws + 32;
    float m_reg = -1e30f, l_reg = 0; f32x16 o[4] = {}; bf16x8 qr[NQ];
    const bf16_t* Ql = Qw + (size_t)r32 * ldq + hi * 8;
#pragma unroll
    for (int d0 = 0; d0 < NQ; ++d0) qr[d0] = gld<bf16x8>(Ql + d0 * 16);
    const char* ql = lds + AL_Q + wid * (NQL * 1024) + lane * 16;
    if constexpr (MLA) {
#pragma unroll
        for (int d0 = NQ; d0 < 12; ++d0) *(bf16x8*)(lds + AL_Q + wid * (NQL * 1024) + (d0 - NQ) * 1024 + lane * 16) = gld<bf16x8>(Ql + d0 * 16);
    }
    const int sr = tid >> 4, sc = (tid & 15) * 8, vst0 = v_st(sr, sc), vst1 = v_st(32 + sr, sc);
    const int rr_ = tid >> 3, rc_ = (tid & 7) * 8;
    const int vb0 = (int)(uintptr_t)V_lds + v_rd_base(lane);
    constexpr int SD = MLA ? MLA_SD : 2;
    struct { bf16x8 vs0, vs1, ks0, ks1; } sr_[SD];
#define SLOAD(i, k0) do { if constexpr (MLA) { \
        sr_[i].ks0 = gld<bf16x8>(&Kg[(size_t)((k0) + sr) * ldk + sc]); sr_[i].ks1 = gld<bf16x8>(&Kg[(size_t)((k0) + 32 + sr) * ldk + sc]); \
        sr_[i].vs0 = gld<bf16x8>(&Kg[(size_t)((k0) + rr_) * ldk + 128 + rc_]); \
    } else { \
        sr_[i].vs0 = gld<bf16x8>(&Vg[(size_t)((k0) + sr) * ldk + sc]); sr_[i].vs1 = gld<bf16x8>(&Vg[(size_t)((k0) + 32 + sr) * ldk + sc]); \
        sr_[i].ks0 = gld<bf16x8>(&Kg[(size_t)((k0) + sr) * ldk + sc]); sr_[i].ks1 = gld<bf16x8>(&Kg[(size_t)((k0) + 32 + sr) * ldk + sc]); } } while (0)
#define SWRITE(b, i) do { const int kc = sc * 2; if constexpr (MLA) { \
        *(bf16x8*)(V_lds + (b) * SHM_V + vst0) = sr_[i].ks0; *(bf16x8*)(V_lds + (b) * SHM_V + vst1) = sr_[i].ks1; \
        *(bf16x8*)(KR_lds + (b) * SHM_KR + KRSWZ(rr_, rc_ * 2)) = sr_[i].vs0; \
    } else { \
        *(bf16x8*)(V_lds + (b) * SHM_V + vst0) = sr_[i].vs0; *(bf16x8*)(V_lds + (b) * SHM_V + vst1) = sr_[i].vs1; } \
        *(bf16x8*)(K_lds + (b) * SHM_K + KSWZ(sr, kc)) = sr_[i].ks0; *(bf16x8*)(K_lds + (b) * SHM_K + KSWZ(32 + sr, kc)) = sr_[i].ks1; } while (0)
#define SWAIT() do { if constexpr (SD == 1) asm volatile("s_waitcnt vmcnt(0)" ::: "memory"); else if constexpr (MLA) asm volatile("s_waitcnt vmcnt(3)" ::: "memory"); else asm volatile("s_waitcnt vmcnt(4)" ::: "memory"); } while (0)
#define RESC(a) do { if (__any((a) < 1.f)) { if (hi == 0) al_l[r32] = (a); asm volatile("s_waitcnt lgkmcnt(0)" ::: "memory"); \
    _Pragma("unroll") for (int d = 0; d < 4; ++d) _Pragma("unroll") for (int r = 0; r < 16; ++r) o[d][r] *= al_l[crow(r, hi)]; } } while (0)
    f32x16 pA0, pA1, pB0, pB1; float mnA, mnB, alA, alB; bf16x8 pa0, pa1, pa2, pa3; const int NT = seq / 64;
    constexpr int SE = 0, SO = SD - 1;
    SLOAD(SE, 0); asm volatile("s_waitcnt vmcnt(0)" ::: "memory"); SWRITE(0, SE); __syncthreads();
    qkt<MLA>(pA0, pA1, K_lds, KR_lds, qr, ql, r32, hi); partialSM<MLA>(pA0, pA1, m_reg, mnA, alA);
    SLOAD(SO, 64); if constexpr (SD == 2) { if (2 < NT) SLOAD(SE, 128); }
    SWAIT(); SWRITE(1, SO); __syncthreads();
    for (int j = 1; j + 1 < NT; j += 2) {
        SBAR(); qkt<MLA>(pB0, pB1, K_lds + SHM_K, KR_lds + SHM_KR, qr, ql, r32, hi);
        finishSM(pA0, pA1, alA, l_reg, pa0, pa1, pa2, pa3); SBAR();
        SLOAD(SO, (j + SD) * 64); SBAR();
        pv_d0(o, vb0, pa0, pa1, pa2, pa3); partialSM<MLA>(pB0, pB1, m_reg, mnB, alB);
        __syncthreads(); SWAIT(); SWRITE(0, SE);
        RESC(alB); __syncthreads();
        SBAR(); qkt<MLA>(pA0, pA1, K_lds, KR_lds, qr, ql, r32, hi);
        finishSM(pB0, pB1, alB, l_reg, pa0, pa1, pa2, pa3); SBAR();
        if (SD == 1 || j + 3 < NT) SLOAD(SE, (j + 1 + SD) * 64); SBAR();
        pv_d0(o, vb0 + SHM_V, pa0, pa1, pa2, pa3); partialSM<MLA>(pA0, pA1, m_reg, mnA, alA);
        __syncthreads(); SWAIT(); SWRITE(1, SO);
        RESC(alA); __syncthreads();
    }
    SBAR(); qkt<MLA>(pB0, pB1, K_lds + SHM_K, KR_lds + SHM_KR, qr, ql, r32, hi);
    finishSM(pA0, pA1, alA, l_reg, pa0, pa1, pa2, pa3); SBAR();
    pv_d0(o, vb0, pa0, pa1, pa2, pa3); partialSM<MLA>(pB0, pB1, m_reg, mnB, alB);
    __syncthreads(); RESC(alB);
    finishSM(pB0, pB1, alB, l_reg, pa0, pa1, pa2, pa3); SBAR();
    pv_d0(o, vb0 + SHM_V, pa0, pa1, pa2, pa3);
    if (hi == 0) li_l[r32] = l_reg; asm volatile("s_waitcnt lgkmcnt(0)" ::: "memory");
    float rli[16];
#pragma unroll
    for (int r = 0; r < 16; ++r) rli[r] = __builtin_amdgcn_rcpf(li_l[crow(r, hi)]);
    if (do_store) {
#pragma unroll
        for (int r = 0; r < 16; ++r) { const int orow = crow(r, hi);
#pragma unroll
            for (int d0 = 0; d0 < 4; ++d0) gst<bf16_t>(Ow + (size_t)orow * ldo + d0 * 32 + r32, f2bf(o[d0][r] * rli[r])); }
    }
    __syncthreads();
#undef SLOAD
#undef SWRITE
#undef SWAIT
#undef RESC
}


constexpr int TB3 = 40960, AL3_WS = 3 * TB3;
static_assert(AL3_WS + 2048 <= LDS_ST, "DMA attention ring overflows into the statistics");
__device__ __forceinline__ void qkt12(f32x16& p0, f32x16& p1, const char* Ks, const char* KRs, const bf16x8* qr, int r32, int hi) {
    p0 = f32x16{}; p1 = f32x16{};
#pragma unroll
    for (int d0 = 0; d0 < 8; ++d0) { const int cb = (d0 * 16 + hi * 8) * 2;
        const bf16x8 b0 = *reinterpret_cast<const bf16x8*>(Ks + KSWZ(r32, cb));
        const bf16x8 b1 = *reinterpret_cast<const bf16x8*>(Ks + KSWZ(32 + r32, cb));
        p0 = __builtin_amdgcn_mfma_f32_32x32x16_bf16(b0, qr[d0], p0, 0, 0, 0);
        p1 = __builtin_amdgcn_mfma_f32_32x32x16_bf16(b1, qr[d0], p1, 0, 0, 0); }
#pragma unroll
    for (int d0 = 0; d0 < 4; ++d0) { const int cb = (d0 * 16 + hi * 8) * 2;
        const bf16x8 b0 = *reinterpret_cast<const bf16x8*>(KRs + KRSWZ(r32, cb));
        const bf16x8 b1 = *reinterpret_cast<const bf16x8*>(KRs + KRSWZ(32 + r32, cb));
        p0 = __builtin_amdgcn_mfma_f32_32x32x16_bf16(b0, qr[8 + d0], p0, 0, 0, 0);
        p1 = __builtin_amdgcn_mfma_f32_32x32x16_bf16(b1, qr[8 + d0], p1, 0, 0, 0); }
}
template <bool MLA, int ldq, int ldk, int ldo>
__device__ __forceinline__ void attn_dma(const bf16_t* __restrict__ Qw, const bf16_t* __restrict__ Kg, const bf16_t* __restrict__ Vg, int seq, bf16_t* __restrict__ Ow, bool do_store, char* lds, const int tid) {
    constexpr int RB = ldk * 2, NQ = MLA ? 12 : 8;
    const int wid = __builtin_amdgcn_readfirstlane(tid >> 6), lane = tid & 63, r32 = lane & 31, hi = lane >> 5;
    float* ws = (float*)(lds + AL3_WS) + wid * 64; float* li_l = ws; float* al_l = ws + 32;
    float m_reg = -1e30f, l_reg = 0; f32x16 o[4] = {}; bf16x8 qr[NQ];
    const bf16_t* Ql = Qw + (size_t)r32 * ldq + hi * 8;
#pragma unroll
    for (int d0 = 0; d0 < NQ; ++d0) qr[d0] = gld<bf16x8>(Ql + d0 * 16);
    unsigned voffK, voffV, voffR;
    { const int G = wid * 64 + lane, row = G >> 4, sl = G & 15; voffK = (unsigned)(row * RB + ((sl ^ (row & 15)) * 16)); }
    { const int G = wid * 64 + lane, sub = G >> 5, r = G & 31, kk = (sub >> 2) * 8 + (r >> 2), k = (kk & ~0xC) | ((kk & 4) << 1) | ((kk & 8) >> 1), c = (sub & 3) * 32 + (r & 3) * 8;
      voffV = (unsigned)(k * RB + c * 2); }
    { const int G = wid * 64 + lane, row = G >> 3, sl = G & 7; voffR = (unsigned)(row * RB + 256 + ((sl ^ ((row >> 1) & 7)) * 16)); }
    const int vrd = v_rd_base(lane);
    LAS unsigned char* ldsl = (LAS unsigned char*)lds;
#define DMA3(boff, t) do { const char* _tb = (const char*)Kg + (size_t)(t) * (64 * RB); const char* _tv = MLA ? _tb : (const char*)Vg + (size_t)(t) * (64 * RB); LAS unsigned char* _lb = ldsl + (boff) + wid * 1024; \
        __builtin_amdgcn_global_load_lds((const unsigned*)(_tb + voffK), (LAS unsigned*)(_lb), 16, 0, 0); \
        __builtin_amdgcn_global_load_lds((const unsigned*)(_tb + 32 * RB + voffK), (LAS unsigned*)(_lb + 8192), 16, 0, 0); \
        __builtin_amdgcn_global_load_lds((const unsigned*)(_tv + voffV), (LAS unsigned*)(_lb + 16384), 16, 0, 0); \
        __builtin_amdgcn_global_load_lds((const unsigned*)(_tv + 32 * RB + voffV), (LAS unsigned*)(_lb + 24576), 16, 0, 0); \
        if constexpr (MLA) __builtin_amdgcn_global_load_lds((const unsigned*)(_tb + voffR), (LAS unsigned*)(_lb + 32768), 16, 0, 0); } while (0)
#define QKT3(P0, P1, boff) do { if constexpr (MLA) qkt12(P0, P1, lds + (boff), lds + (boff) + 32768, qr, r32, hi); else qkt<false>(P0, P1, lds + (boff), nullptr, qr, nullptr, r32, hi); } while (0)
#define RESC3(a) do { if (__any((a) < 1.f)) { if (hi == 0) al_l[r32] = (a); asm volatile("s_waitcnt lgkmcnt(0)" ::: "memory"); \
    _Pragma("unroll") for (int d = 0; d < 4; ++d) _Pragma("unroll") for (int r = 0; r < 16; ++r) o[d][r] *= al_l[crow(r, hi)]; } } while (0)
#define VB3(boff) ((int)(uintptr_t)(lds + (boff) + 16384) + vrd)
    f32x16 pA0, pA1, pB0, pB1; float mnA, mnB, alA, alB; bf16x8 pa0, pa1, pa2, pa3; const int NT = seq / 64;
    int bp = 0, bc = TB3, bn = 2 * TB3;
    const bool cmp = MLA || do_store;
    if (!cmp) { pA0 = f32x16{}; pA1 = f32x16{}; pB0 = f32x16{}; pB1 = f32x16{}; mnA = mnB = 0.f; alA = alB = 1.f; pa0 = pa1 = pa2 = pa3 = bf16x8{}; }
    DMA3(0, 0); DMA3(TB3, 1);
    asm volatile("s_waitcnt vmcnt(0)" ::: "memory"); __syncthreads();
    if (cmp) { QKT3(pA0, pA1, 0); partialSM<MLA>(pA0, pA1, m_reg, mnA, alA); }
    for (int j = 1; j + 1 < NT; j += 2) {
        DMA3(bn, j + 1);
        if (cmp) { QKT3(pB0, pB1, bc);
        finishSM(pA0, pA1, alA, l_reg, pa0, pa1, pa2, pa3);
        pv_d0(o, VB3(bp), pa0, pa1, pa2, pa3); partialSM<MLA>(pB0, pB1, m_reg, mnB, alB); }
        asm volatile("s_waitcnt vmcnt(0)" ::: "memory"); __syncthreads();
        if (cmp) { RESC3(alB); }
        { const int t_ = bp; bp = bc; bc = bn; bn = t_; }
        if (j + 2 < NT) DMA3(bn, j + 2);
        if (cmp) { QKT3(pA0, pA1, bc);
        finishSM(pB0, pB1, alB, l_reg, pa0, pa1, pa2, pa3);
        pv_d0(o, VB3(bp), pa0, pa1, pa2, pa3); partialSM<MLA>(pA0, pA1, m_reg, mnA, alA); }
        asm volatile("s_waitcnt vmcnt(0)" ::: "memory"); __syncthreads();
        if (cmp) { RESC3(alA); }
        { const int t_ = bp; bp = bc; bc = bn; bn = t_; }
    }
    if (cmp) {
    SBAR(); QKT3(pB0, pB1, bc);
    finishSM(pA0, pA1, alA, l_reg, pa0, pa1, pa2, pa3); SBAR();
    pv_d0(o, VB3(bp), pa0, pa1, pa2, pa3); partialSM<MLA>(pB0, pB1, m_reg, mnB, alB);
    RESC3(alB);
    finishSM(pB0, pB1, alB, l_reg, pa0, pa1, pa2, pa3); SBAR();
    pv_d0(o, VB3(bc), pa0, pa1, pa2, pa3); }
    if (hi == 0) li_l[r32] = l_reg; asm volatile("s_waitcnt lgkmcnt(0)" ::: "memory");
    float rli[16];
#pragma unroll
    for (int r = 0; r < 16; ++r) rli[r] = __builtin_amdgcn_rcpf(li_l[crow(r, hi)]);
    if (do_store) {
#pragma unroll
    for (int r = 0; r < 16; ++r) { const int orow = crow(r, hi);
#pragma unroll
        for (int d0 = 0; d0 < 4; ++d0) gst<bf16_t>(Ow + (size_t)orow * ldo + d0 * 32 + r32, f2bf(o[d0][r] * rli[r])); }
    }
    __syncthreads();
#undef QKT3
#undef DMA3
#undef RESC3
#undef VB3
}

enum { MAP_PLAIN = 0, MAP_FFN_IN, MAP_SGU_IN, MAP_MLA_IN };
__device__ __forceinline__ int map_col(int mode, int n0) {
    if (mode == MAP_FFN_IN) { const int pn = n0 >> 8, w = n0 & 255; return (w >> 7) * DFF + pn * 128 + (w & 127); }
    if (mode == MAP_SGU_IN) { return n0 < 1536 ? n0 : (n0 < 2048 ? 3072 + (n0 - 1536) : 1536 + (n0 - 2048)); }
    if (mode == MAP_MLA_IN) { return n0 < 448 ? n0 : (n0 < 512 ? -1 : 448 + (n0 - 512)); }
    return n0;
}
__device__ __forceinline__ int cvtT(const float* __restrict__ src, int sld, int K, int N, bf16_t* __restrict__ dst, const float* __restrict__ gain, float scale, int mode, float* tile, const int tid, int& tnext, int tbase) {
    const int ntk = K / 64, ntn = N / 256, tx = tid & 63, ty = tid >> 6;
    for (; tnext < tbase + ntk * ntn; tnext += NCU) {
        const int t = tnext - tbase, nb = t / ntk, kb = t % ntk; const int sc = map_col(mode, nb * 256 + (tx >> 4) * 64);
        __syncthreads();
        f32x4 v[8];
#pragma unroll
        for (int ps = 0; ps < 8; ++ps) { v[ps] = (f32x4){0.f, 0.f, 0.f, 0.f}; if (sc >= 0) v[ps] = gld<f32x4>(src + (size_t)(kb * 64 + ps * 8 + ty) * sld + sc + (tx & 15) * 4); }
#pragma unroll
        for (int ps = 0; ps < 8; ++ps) { const int kk = ps * 8 + ty; const float g = gain ? gld<float>(gain + kb * 64 + kk) * scale : scale; *(f32x4*)(tile + kk * 260 + tx * 4) = v[ps] * g; }
        __syncthreads();
#pragma unroll
        for (int q = 0; q < 4; ++q) {
            const int item = q * 512 + tid, n = item & 255, k8 = (item >> 8) * 8;
            u32x4 w;
            w[0] = cvtpk(tile[(k8 + 0) * 260 + n], tile[(k8 + 1) * 260 + n]); w[1] = cvtpk(tile[(k8 + 2) * 260 + n], tile[(k8 + 3) * 260 + n]);
            w[2] = cvtpk(tile[(k8 + 4) * 260 + n], tile[(k8 + 5) * 260 + n]); w[3] = cvtpk(tile[(k8 + 6) * 260 + n], tile[(k8 + 7) * 260 + n]);
            gst<u32x4>(dst + (size_t)(nb * 256 + n) * K + kb * 64 + k8, w);
        }
    }
    return tbase + ntk * ntn;
}

enum { OP_PREP = 0, OP_GSYNC, OP_G_MEMKV, OP_G_FFN1, OP_G_FFN2, OP_G_SGU_IN, OP_MIX, OP_MEMATT, OP_G_SGU_OUT, OP_G_MLA_IN, OP_KVPOST, OP_G_MLA_Q, OP_MLA_ATT, OP_G_MLA_OUT, OP_FINAL };
#define PC(op, l, sub) (unsigned char)((op) | ((l) << 4) | ((sub) << 6))
#define SGU_LAYER(l) PC(OP_G_FFN1, l, 0), PC(OP_G_FFN2, l, 0), PC(OP_G_SGU_IN, l, 0), PC(OP_MIX, l, 0), PC(OP_MEMATT, l, 0), PC(OP_G_SGU_OUT, l, 0), PC(OP_G_FFN1, l, 1), PC(OP_G_FFN2, l, 1)
#define MLA_LAYER(l) PC(OP_G_FFN1, l, 0), PC(OP_G_FFN2, l, 0), PC(OP_G_MLA_IN, l, 0), PC(OP_KVPOST, l, 0), PC(OP_G_MLA_Q, l, 0), PC(OP_GSYNC, l, 0), PC(OP_MLA_ATT, l, 0), PC(OP_MEMATT, l, 0), PC(OP_G_MLA_OUT, l, 0), PC(OP_G_FFN1, l, 1), PC(OP_G_FFN2, l, 1)
constexpr int NPROG = 46;
__constant__ unsigned char PROG[NPROG] = {
    PC(OP_PREP, 0, 0), PC(OP_GSYNC, 0, 0), PC(OP_G_MEMKV, 0, 0), PC(OP_GSYNC, 0, 0),
    SGU_LAYER(0), MLA_LAYER(1),
    PC(OP_GSYNC, 0, 0), PC(OP_PREP, 2, 0), PC(OP_GSYNC, 0, 0),
    SGU_LAYER(2), MLA_LAYER(3),
    PC(OP_FINAL, 0, 0) };

__global__ __launch_bounds__(512, 2) void fwd_megakernel(Params p) {
    extern __shared__ __attribute__((aligned(16))) unsigned char shm[];
    cg::grid_group grid = cg::this_grid();
    const int cu = blockIdx.x;
    LAS unsigned char* lds = (LAS unsigned char*)shm;
    float* st = (float*)(shm + LDS_ST);
    float* st_rsx = st, *st_rv = st + 256, *st_rq = st + 512, *st_xacc = st + 1024, *st_vacc = st + 2048, *st_qacc = st + 3072;
    float* tile = (float*)shm;
    const float** tab = (const float**)(shm + LDS_TAB);
    if (threadIdx.x < 26) tab[threadIdx.x] = p.in[threadIdx.x];
    __syncthreads();
#define PIN(i) as_global(((const float* volatile*)tab)[i])
    grid.sync();
    int nsync = 0;
    for (int pc = 0; pc < NPROG; ++pc) {
        int tid = threadIdx.x; asm volatile("" : "+v"(tid));
        const int wid = tid >> 6, lane = tid & 63;
        unsigned char* ws = p.ws; float* outp = p.out; asm volatile("" : "+s"(ws), "+s"(outp)); ws = as_global(ws); outp = as_global(outp);
        bf16_t* X = (bf16_t*)outp;
        unsigned char* slab = ws + WS_SCR + (size_t)cu * SLAB;
        bf16_t* HID = (bf16_t*)(slab + SCR_HID);
        bf16_t* Pb = (bf16_t*)(slab + SCR_P);
        bf16_t* VT = (bf16_t*)(slab + SCR_VT);
        bf16_t* QF = (bf16_t*)(slab + SCR_QF);
        bf16_t* C2 = (bf16_t*)(slab + SCR_C2);
        bf16_t* KB = (bf16_t*)(ws + WS_KBUF);
        bf16_t* MEMKV = (bf16_t*)(ws + WS_MEMKV);
        float* kvraw = (float*)(C2 + 256);
        const float* rcos = (const float*)(ws + WS_ROPE); const float* rsin = rcos + 16384 * 32;
        const size_t hstepTok = (size_t)TPROMPT * 2;
        const size_t hstepLoc = (size_t)128 * 2;

#ifdef RUN_UNTIL
        if (pc >= RUN_UNTIL && pc != NPROG - 1) continue;
#endif
        const int code = PROG[pc], op = code & 15, l = (code >> 4) & 3, sub = (code >> 6) & 1, dup = code >> 7, j = l >> 1;
        unsigned char* slot = ws + ((l & 1) ? WS_SLOTB : WS_SLOTA);
        const bool is_gemm = (op == OP_G_MEMKV || op == OP_G_FFN1 || op == OP_G_FFN2 || op == OP_G_SGU_IN || op == OP_G_SGU_OUT || op == OP_G_MLA_IN || op == OP_G_MLA_Q || op == OP_G_MLA_OUT);
        if (is_gemm) {
            GemmArgs g{}; Epi e{}; e.cu = cu; e.ws = ws; e.out = outp; e.st = st; e.alpha = 1.f; bool run = true;
            if (op == OP_G_MEMKV) {
                run = cu < 96; const int ll = cu / 24, rem = cu % 24, rb = rem >> 2, pn = rem & 3;
                g.A = (const bf16_t*)(ws + WS_MEMN) + (size_t)rb * 256 * 1024; g.hstepA = (size_t)128 * 1024 * 2; g.lda = 1024;
                g.Bt = (const bf16_t*)(ws + WS_MEMW) + ((size_t)ll * 1024 + pn * 256) * 1024; g.K = 1024; g.nN = 1;
                e.mode = EP_MEMKV;
            } else if (op == OP_G_FFN1) {
                g.A = X + (size_t)cu * 128 * XLD; g.hstepA = hstepTok * XLD; g.lda = XLD; g.Bt = (const bf16_t*)(slot + (sub == 0 ? SL_F1I : SL_F2I)); g.K = 1024; g.nN = 22;
                e.mode = EP_FFN1;
            } else if (op == OP_G_FFN2) {
                g.A = HID; g.hstepA = hstepLoc * HID_LD; g.lda = HID_LD; g.Bt = (const bf16_t*)(slot + (sub == 0 ? SL_F1O : SL_F2O)); g.K = 2816; g.nN = 4;
                e.mode = EP_XUPD; e.alpha = dup ? 0.f : 0.5f;
            } else if (op == OP_G_SGU_IN) {
                g.A = X + (size_t)cu * 128 * XLD; g.hstepA = hstepTok * XLD; g.lda = XLD; g.Bt = (const bf16_t*)(slot + SG_IN); g.K = 1024; g.nN = 14;
                e.mode = EP_SGU_IN;
                if (tid < 256) { st_vacc[tid] = 0.f; st_vacc[256 + tid] = 0.f; st_vacc[512 + tid] = 0.f; st_vacc[768 + tid] = 0.f; }
            } else if (op == OP_G_SGU_OUT) {
                g.A = Pb; g.hstepA = hstepLoc * P_LD; g.lda = P_LD; g.Bt = (const bf16_t*)(slot + SG_OUT); g.K = 2048; g.nN = 4;
                e.mode = EP_XUPD; e.alpha = 1.0f;
            } else if (op == OP_G_MLA_IN) {
                g.A = X + (size_t)cu * 128 * XLD; g.hstepA = hstepTok * XLD; g.lda = XLD; g.Bt = (const bf16_t*)(slot + ML_IN); g.K = 1024; g.nN = 4;
                e.mode = EP_MLA_IN;
                if (tid < 256) { st_qacc[tid] = 0.f; st_qacc[256 + tid] = 0.f; st_qacc[512 + tid] = 0.f; st_qacc[768 + tid] = 0.f; }
            } else if (op == OP_G_MLA_Q) {
                g.A = C2; g.hstepA = hstepLoc * C2_LD; g.lda = C2_LD; g.Bt = (const bf16_t*)(slot + ML_Q); g.K = 256; g.nN = 6;
                e.mode = EP_MLA_Q;
            } else {
                g.A = C2; g.hstepA = hstepLoc * C2_LD; g.lda = C2_LD; g.Bt = (const bf16_t*)(slot + ML_OUT); g.K = 1536; g.nN = 4;
                e.mode = EP_XUPD; e.alpha = 1.0f;
            }
            __syncthreads();
            if (run) gemm_phase(lds, g, e, tid);
            if (tid < 256) {
                if (e.mode == EP_XUPD) { st_rsx[tid] = rsqrtf(((st_xacc[tid] + st_xacc[256 + tid]) + (st_xacc[512 + tid] + st_xacc[768 + tid])) * (1.f / 1024.f) + EPS); st_xacc[tid] = 0.f; st_xacc[256 + tid] = 0.f; st_xacc[512 + tid] = 0.f; st_xacc[768 + tid] = 0.f; }
                else if (e.mode == EP_SGU_IN) st_rv[tid] = rsqrtf(((st_vacc[tid] + st_vacc[256 + tid]) + (st_vacc[512 + tid] + st_vacc[768 + tid])) * (1.f / 1536.f) + EPS);
                else if (e.mode == EP_MLA_IN) st_rq[tid] = rsqrtf(((st_qacc[tid] + st_qacc[256 + tid]) + (st_qacc[512 + tid] + st_qacc[768 + tid])) * (1.f / 256.f) + EPS);
            }
            __syncthreads();
        } else if (op == OP_GSYNC) {
            __builtin_amdgcn_fence(__ATOMIC_RELEASE, "agent"); asm volatile("s_waitcnt vmcnt(0) lgkmcnt(0)" ::: "memory");
            __syncthreads();
            ++nsync;
            if (tid == 0) {
                unsigned* bar = (unsigned*)(ws + WS_BAR);
                __hip_atomic_fetch_add(bar, 1u, __ATOMIC_RELAXED, __HIP_MEMORY_SCOPE_AGENT);
                while (__hip_atomic_load(bar, __ATOMIC_RELAXED, __HIP_MEMORY_SCOPE_AGENT) < (unsigned)(NCU * nsync)) __builtin_amdgcn_s_sleep(4);
            }
            __syncthreads();
            __builtin_amdgcn_fence(__ATOMIC_ACQUIRE, "agent"); asm volatile("s_waitcnt vmcnt(0) lgkmcnt(0)" ::: "memory");
            __syncthreads();
        } else if (op == OP_PREP) {
            const int nitems = (l == 0) ? 16 : 12; int tnext = cu, tbase = 0;
            for (int item = 0; item < nitems; ++item) {
                const float* src; int sld, K, N, mode = MAP_PLAIN; bf16_t* dst; const float* gain = nullptr; bool skip = false;
                if (item < 12) {
                    const int ll = l + item / 6, m = item % 6; unsigned char* sl = ws + ((ll & 1) ? WS_SLOTB : WS_SLOTA); const int jj = ll >> 1;
                    if (m == 0 || m == 2) { src = PIN(m == 0 ? 5 : 11) + (size_t)ll * 1024 * 5632; sld = 5632; K = 1024; N = 5632; dst = (bf16_t*)(sl + (m == 0 ? SL_F1I : SL_F2I)); gain = PIN(m == 0 ? 4 : 10) + ll * 1024; mode = MAP_FFN_IN; }
                    else if (m == 1 || m == 3) { src = PIN(m == 1 ? 6 : 12) + (size_t)ll * 2816 * 1024; sld = 1024; K = 2816; N = 1024; dst = (bf16_t*)(sl + (m == 1 ? SL_F1O : SL_F2O)); }
                    else if (m == 4) {
                        if ((ll & 1) == 0) { src = PIN(13) + (size_t)jj * 1024 * 3584; sld = 3584; K = 1024; N = 3584; dst = (bf16_t*)(sl + SG_IN); gain = PIN(7) + ll * 1024; mode = MAP_SGU_IN; }
                        else { src = PIN(18) + (size_t)jj * 1024 * 960; sld = 960; K = 1024; N = 1024; dst = (bf16_t*)(sl + ML_IN); gain = PIN(7) + ll * 1024; mode = MAP_MLA_IN; }
                    } else {
                        if ((ll & 1) == 0) { src = PIN(17) + (size_t)jj * 2048 * 1024; sld = 1024; K = 2048; N = 1024; dst = (bf16_t*)(sl + SG_OUT); }
                        else { skip = true; src = nullptr; sld = K = N = 64; dst = nullptr; }
                    }
                } else { const int ll = item - 12; src = PIN(9) + (size_t)ll * 1024 * 1024; sld = 1024; K = 1024; N = 1024; dst = (bf16_t*)(ws + WS_MEMW) + (size_t)ll * 1024 * 1024; gain = PIN(8) + ll * 1024; }
                if (!skip) tbase = cvtT(src, sld, K, N, dst, gain, 1.f, mode, tile, tid, tnext, tbase);
            }
            __syncthreads();
            const size_t gt = (size_t)cu * NTHR + tid, gn = (size_t)NCU * NTHR;
            {
                const int jj = l >> 1; const float* wsp = PIN(15) + (size_t)jj * 8 * 128 * 128; bf16_t* d = (bf16_t*)(ws + WS_SLOTA + SG_WS);
                for (size_t i = gt; i < (size_t)8 * 128 * 128; i += gn) d[i] = f2bf(wsp[i]);
            }
            {
                const int jj = l >> 1; unsigned char* sl = ws + WS_SLOTB;
                const float* wuq = PIN(20) + (size_t)jj * 256 * 1536; const float* wuk = PIN(22) + (size_t)jj * 128 * 8 * 128; const float* qn = PIN(19) + jj * 256;
                bf16_t* dq = (bf16_t*)(sl + ML_Q); const float qs = 0.07216878364870322f;
                for (size_t i = gt; i < (size_t)1536 * 256; i += gn) {
                    const int n = (int)(i >> 8), k = (int)(i & 255); float v;
                    if (n < 1024) { const int h = n >> 7, c = n & 127; const float* a = wuq + (size_t)k * 1536 + h * 192; const float* b = wuk + ((size_t)c * 8 + h) * 128; float sacc = 0.f;
                        for (int d = 0; d < 128; d += 4) { const f32x4 x = *(const f32x4*)(a + d), y = *(const f32x4*)(b + d); sacc += x[0] * y[0] + x[1] * y[1] + x[2] * y[2] + x[3] * y[3]; } v = sacc; }
                    else { const int rem = n - 1024, t = rem >> 8, w = rem & 255, half = w >> 7, hh = (w & 127) >> 5, j2 = w & 31; v = wuq[(size_t)k * 1536 + (4 * t + hh) * 192 + 128 + 32 * half + j2]; }
                    dq[i] = f2bf(v * qn[k] * qs);
                }
                const float* wuv = PIN(23) + (size_t)jj * 128 * 8 * 128; const float* wo = PIN(24) + (size_t)jj * 1536 * 1024; bf16_t* dout = (bf16_t*)(sl + ML_OUT);
                for (size_t i = gt; i < (size_t)8 * 64 * 256; i += gn) {
                    const int n = (int)(i & 255) * 4, c = (int)((i >> 8) & 63) * 2, h = (int)(i >> 14);
                    const float* a0 = wuv + ((size_t)c * 8 + h) * 128; const float* a1 = a0 + 8 * 128; const float* b = wo + (size_t)(h * 128) * 1024 + n;
                    f32x4 s0 = {0.f, 0.f, 0.f, 0.f}, s1 = {0.f, 0.f, 0.f, 0.f};
#pragma unroll 8
                    for (int d = 0; d < 128; ++d) { const f32x4 bv = *(const f32x4*)(b + (size_t)d * 1024); s0 += bv * a0[d]; s1 += bv * a1[d]; }
                    const int kk = h * 128 + c;
#pragma unroll
                    for (int q = 0; q < 4; ++q) *(unsigned*)(dout + (size_t)(n + q) * 1536 + kk) = cvtpk(s0[q], s1[q]);
                }
                for (size_t i = gt; i < (size_t)512 * 256; i += gn) {
                    const int kk = 1024 + (int)(i >> 8), n = (int)(i & 255) * 4; const f32x4 v = *(const f32x4*)(wo + (size_t)kk * 1024 + n);
#pragma unroll
                    for (int q = 0; q < 4; ++q) dout[(size_t)(n + q) * 1536 + kk] = f2bf(v[q]);
                }
            }
            if (l == 0) {
                {
                    bf16_t* memn = (bf16_t*)(ws + WS_MEMN);
                    for (int r = cu * 8 + wid; r < 1536; r += NCU * 8) {
                        const float* src = r < 1024 ? PIN(2) + (size_t)r * 1024 : PIN(3) + (size_t)(r - 1024) * 1024;
                        f32x4 v[4]; float ss = 0.f;
#pragma unroll
                        for (int q = 0; q < 4; ++q) { v[q] = *(const f32x4*)(src + q * 256 + lane * 4); ss += v[q][0] * v[q][0] + v[q][1] * v[q][1] + v[q][2] * v[q][2] + v[q][3] * v[q][3]; }
                        ss = wave_sum(ss); const float rs = rsqrtf(ss * (1.f / 1024.f) + EPS);
#pragma unroll
                        for (int q = 0; q < 4; ++q) { u32x2 w; w[0] = cvtpk(v[q][0] * rs, v[q][1] * rs); w[1] = cvtpk(v[q][2] * rs, v[q][3] * rs); *(u32x2*)(memn + (size_t)r * 1024 + q * 256 + lane * 4) = w; }
                    }
                }
                {
                    float* c = (float*)(ws + WS_ROPE); float* s = c + 16384 * 32;
                    for (int i = cu * NTHR + tid; i < 16384 * 32; i += NCU * NTHR) {
                        const int pos = i >> 5, jj = i & 31;
                        double bp = 1.0; for (int t = 0; t < jj; ++t) bp *= 1.333521432163324;
                        const float invf = 1.0f / (float)bp;
                        const float ang = (float)pos * invf;
                        const double ad = (double)ang, kq = rint(ad * 0.6366197723675814);
                        const double r = (ad - kq * 1.5707963267948966) - kq * 6.123233995736766e-17, r2 = r * r;
                        const double sr = r * (1.0 + r2 * (-1.0 / 6 + r2 * (1.0 / 120 + r2 * (-1.0 / 5040 + r2 * (1.0 / 362880 + r2 * (-1.0 / 39916800 + r2 * (1.0 / 6227020800.0)))))));
                        const double cr = 1.0 + r2 * (-0.5 + r2 * (1.0 / 24 + r2 * (-1.0 / 720 + r2 * (1.0 / 40320 + r2 * (-1.0 / 3628800 + r2 * (1.0 / 479001600.0 + r2 * (-1.0 / 87178291200.0)))))));
                        const int qd = ((int)kq) & 3;
                        const double sd = (qd == 0) ? sr : (qd == 1) ? cr : (qd == 2) ? -sr : -cr;
                        const double cd = (qd == 0) ? cr : (qd == 1) ? -sr : (qd == 2) ? -cr : sr;
                        c[i] = (float)cd; s[i] = (float)sd;
                    }
                }
                {
                    for (int rr = wid; rr < 256; rr += 8) {
                        const int ai = rr >> 7, pr = rr & 127; const size_t tl = (size_t)cu * 128 + pr;
                        const float* src = (ai ? PIN(1) : PIN(0)) + tl * 1024;
                        bf16_t* dst = X + ((size_t)ai * TPROMPT + tl) * XLD;
                        f32x4 v[4]; float ss = 0.f;
#pragma unroll
                        for (int q = 0; q < 4; ++q) { v[q] = *(const f32x4*)(src + q * 256 + lane * 4); ss += v[q][0] * v[q][0] + v[q][1] * v[q][1] + v[q][2] * v[q][2] + v[q][3] * v[q][3]; }
                        ss = wave_sum(ss);
#pragma unroll
                        for (int q = 0; q < 4; ++q) {
                            u32x2 h, lo; h[0] = cvtpk(v[q][0], v[q][1]); h[1] = cvtpk(v[q][2], v[q][3]);
                            lo[0] = cvtpk(v[q][0] - bflo(h[0]), v[q][1] - bfhi(h[0])); lo[1] = cvtpk(v[q][2] - bflo(h[1]), v[q][3] - bfhi(h[1]));
                            *(u32x2*)(dst + q * 256 + lane * 4) = h; if (XLO) *(u32x2*)(dst + 1024 + q * 256 + lane * 4) = lo;
                        }
                        if (lane == 0) st_rsx[rr] = rsqrtf(ss * (1.f / 1024.f) + EPS);
                    }
                    if (tid < 256) { st_xacc[tid] = 0.f; st_xacc[256 + tid] = 0.f; st_xacc[512 + tid] = 0.f; st_xacc[768 + tid] = 0.f; }
                }
            }
        } else if (op == OP_MIX) {
#ifndef NO_MIX
            const int gi = wid, fr = lane & 15, fq = lane >> 4;
            const bf16_t* Wsg = (const bf16_t*)(slot + SG_WS) + (size_t)gi * 128 * 128;
            const float* vgain = PIN(14) + j * 1536 + gi * 192; const float* bs = PIN(16) + (size_t)j * 8 * 128 + gi * 128;
            for (int ai = 0; ai < 2; ++ai) {
                float rvq[4][8];
#pragma unroll
                for (int ks = 0; ks < 4; ++ks)
#pragma unroll
                    for (int i = 0; i < 8; ++i) rvq[ks][i] = st_rv[ai * 128 + ks * 32 + fq * 8 + i];
                const bf16_t* vtg = VT + ((size_t)ai * 1536 + gi * 192) * 128;
                for (int ph = 0; ph < 2; ++ph) {
                    bf16x8 bw[4][4];
#pragma unroll
                    for (int pb = 0; pb < 4; ++pb)
#pragma unroll
                        for (int ks = 0; ks < 4; ++ks) bw[pb][ks] = gld<bf16x8>(Wsg + (size_t)(ph * 64 + pb * 16 + fr) * 128 + ks * 32 + fq * 8);
                    for (int cb = 0; cb < 12; ++cb) {
                        bf16x8 af[4];
#pragma unroll
                        for (int ks = 0; ks < 4; ++ks) {
                            const u32x4 raw = gld<u32x4>(vtg + (size_t)(cb * 16 + fr) * 128 + ks * 32 + fq * 8);
                            u32x4 w;
#pragma unroll
                            for (int i = 0; i < 4; ++i) w[i] = cvtpk(bflo(raw[i]) * rvq[ks][2 * i], bfhi(raw[i]) * rvq[ks][2 * i + 1]);
                            af[ks] = *reinterpret_cast<bf16x8*>(&w);
                        }
                        f32x4 d[4];
#pragma unroll
                        for (int pb = 0; pb < 4; ++pb) { d[pb] = (f32x4){0.f, 0.f, 0.f, 0.f};
#pragma unroll
                            for (int ks = 0; ks < 4; ++ks) d[pb] = __builtin_amdgcn_mfma_f32_16x16x32_bf16(af[ks], bw[pb][ks], d[pb], 0, 0, 0); }
                        const f32x4 gn = gld<f32x4>(vgain + cb * 16 + fq * 4);
#pragma unroll
                        for (int pb = 0; pb < 4; ++pb) {
                            const int pr = ph * 64 + pb * 16 + fr; const float bb = gld<float>(bs + pr);
                            bf16_t* up = Pb + (size_t)(ai * 128 + pr) * P_LD + gi * 192 + cb * 16 + fq * 4;
                            const u32x2 uw = gld<u32x2>(up);
                            u32x2 w; w[0] = cvtpk(bflo(uw[0]) * (gn[0] * d[pb][0] + bb), bfhi(uw[0]) * (gn[1] * d[pb][1] + bb));
                            w[1] = cvtpk(bflo(uw[1]) * (gn[2] * d[pb][2] + bb), bfhi(uw[1]) * (gn[3] * d[pb][3] + bb));
                            gst<u32x2>(up, w);
                        }
                    }
                }
            }
            __syncthreads();
#endif
        } else if (op == OP_MEMATT) {
#ifndef NO_MEMATT
            static_assert(P_LD == C2_LD, "one row stride for both concat buffers"); bf16_t* buf = (l & 1) ? C2 : Pb; constexpr int ld = P_LD; const int qoff = (l & 1) ? 1024 : 1536;
            for (int it = 0; it < 8; ++it) {
                int t2 = tid; asm volatile("" : "+v"(t2)); const int wid = t2 >> 6;
                const int ai = it >> 2, h = it & 3; const int mb = ai ? 4 + (cu >> 7) : (cu >> 6);
                const bf16_t* kg = MEMKV + ((size_t)l * 1536 + mb * 256) * 1024 + h * 128;
                bf16_t* q = buf + (size_t)(ai * 128 + (wid & 3) * 32) * ld + qoff + h * 128;
                #if MLA_DMA
                attn_dma<false, P_LD, 1024, P_LD>(q, kg, kg + 512, 256, q, wid < 4, (char*)shm, t2);
#else
                attn_body<false, P_LD, 1024, P_LD>(q, kg, kg + 512, 256, q, wid < 4, (char*)shm, t2);
#endif
            }
#endif
        } else if (op == OP_KVPOST) {
            const float* kvg = PIN(21) + j * 128;
            for (int rr = wid; rr < 256; rr += 8) {
                const int ai = rr >> 7, pr = rr & 127; const size_t g = (size_t)ai * TPROMPT + (size_t)cu * 128 + pr;
                const float* src = kvraw + (size_t)rr * (C2_LD / 2);
                const float a0 = src[lane * 2], a1 = src[lane * 2 + 1];
                const float ss = wave_sum(a0 * a0 + a1 * a1); const float rs = rsqrtf(ss * (1.f / 128.f) + EPS);
                bf16_t* kd = KB + g * K_LD;
                *(unsigned*)(kd + lane * 2) = cvtpk(a0 * rs * kvg[lane * 2], a1 * rs * kvg[lane * 2 + 1]);
                if (lane < 32) {
                    const int pos = (cu * 128 + pr) & (ai ? 16383 : 8191);
                    const float x1 = src[128 + lane], x2 = src[160 + lane], c = rcos[pos * 32 + lane], s = rsin[pos * 32 + lane];
                    kd[128 + lane] = f2bf(x1 * c - x2 * s); kd[160 + lane] = f2bf(x1 * s + x2 * c);
                }
            }
            __syncthreads();
        } else if (op == OP_MLA_ATT) {
#ifndef NO_MLAATT
            for (int it = 0; it < 8; ++it) {
                int t2 = tid; asm volatile("" : "+v"(t2)); const int wid = t2 >> 6;
                const int ai = it >> 2, hp = it & 3; const int seq = ai ? 16384 : 8192;
                const size_t g0 = (size_t)ai * TPROMPT + (size_t)cu * 128;
                const size_t s0 = (size_t)ai * TPROMPT + ((size_t)cu * 128 / seq) * seq;
                const int head = 2 * hp + (wid >> 2);
                const size_t lrow0 = (size_t)(ai * 128 + (wid & 3) * 32);
                #if MLA_DMA
                attn_dma<true, QF_LD, K_LD, C2_LD>(QF + lrow0 * QF_LD + head * 192, KB + s0 * K_LD, nullptr, seq, C2 + lrow0 * C2_LD + head * 128, true, (char*)shm, t2);
#else
                attn_body<true, QF_LD, K_LD, C2_LD>(QF + lrow0 * QF_LD + head * 192, KB + s0 * K_LD, nullptr, seq, C2 + lrow0 * C2_LD + head * 128, true, (char*)shm, t2);
#endif
            }
#endif
        } else {
            const float* fg = PIN(25);
            for (int rr = wid; rr < 256; rr += 8) {
                const int ai = rr >> 7, pr = rr & 127; const size_t g = (size_t)ai * TPROMPT + (size_t)cu * 128 + pr;
                bf16_t* row = X + g * XLD; const float rs = st_rsx[rr];
                u32x2 h[4], lo[4];
#pragma unroll
                for (int q = 0; q < 4; ++q) { h[q] = *(const u32x2*)(row + q * 256 + lane * 4); lo[q] = (u32x2){0u, 0u}; if (XLO) lo[q] = *(const u32x2*)(row + 1024 + q * 256 + lane * 4); }
                asm volatile("s_waitcnt vmcnt(0)" ::: "memory");
                float* orow = (float*)row;
#pragma unroll
                for (int q = 0; q < 4; ++q) {
                    const f32x4 gq = *(const f32x4*)(fg + q * 256 + lane * 4);
                    f32x4 y; y[0] = (bflo(h[q][0]) + bflo(lo[q][0])) * rs * gq[0]; y[1] = (bfhi(h[q][0]) + bfhi(lo[q][0])) * rs * gq[1];
                    y[2] = (bflo(h[q][1]) + bflo(lo[q][1])) * rs * gq[2]; y[3] = (bfhi(h[q][1]) + bfhi(lo[q][1])) * rs * gq[3];
                    *(f32x4*)(orow + q * 256 + lane * 4) = y;
                }
            }
        }
    }
}

extern "C" void kernel_launch(void* const* d_in, const int* in_sizes, int n_in, void* d_out, int out_size, void* d_ws, size_t ws_size, hipStream_t stream) {
    static int ready = 0;
    if (ready == 0) {
        if (n_in != 26 || out_size != NTOK * DM || ws_size < WS_END) { fprintf(stderr, "kernel_launch: unexpected shapes (n_in %d out %d ws %zu need %zu)\n", n_in, out_size, ws_size, (size_t)WS_END); ready = -1; return; }
        if (hipFuncSetAttribute((const void*)fwd_megakernel, hipFuncAttributeMaxDynamicSharedMemorySize, LDS_TOTAL) != hipSuccess) { fprintf(stderr, "kernel_launch: hipFuncSetAttribute failed\n"); ready = -1; return; }
        int per_cu = 0; (void)hipOccupancyMaxActiveBlocksPerMultiprocessor(&per_cu, (const void*)fwd_megakernel, NTHR, LDS_TOTAL); (void)hipGetLastError();
        ready = 1;
    }
    if (ready < 0) return;
    Params p{};
    for (int i = 0; i < 26; ++i) p.in[i] = (const float*)d_in[i];
    p.out = (float*)d_out; p.ws = (unsigned char*)d_ws;
    if (hipMemsetAsync((unsigned char*)d_ws + WS_BAR, 0, 256, stream) != hipSuccess) { fprintf(stderr, "kernel_launch: memset of the barrier word failed\n"); return; }
    void* args[] = {&p};
    hipError_t e = hipLaunchCooperativeKernel((const void*)fwd_megakernel, dim3(NCU), dim3(NTHR), args, LDS_TOTAL, stream);
    if (e != hipSuccess) fprintf(stderr, "kernel_launch: cooperative launch failed: %s\n", hipGetErrorString(e));
}
```

```cpp
#include <hip/hip_runtime.h>
#include <hip/hip_cooperative_groups.h>
#include <cstdio>
#include <cstdint>
namespace cg = cooperative_groups;

#define LAS __attribute__((address_space(3)))
typedef unsigned short bf16_t;
typedef short bf16x8 __attribute__((ext_vector_type(8)));
typedef short s16x4 __attribute__((ext_vector_type(4)));
typedef float f32x4 __attribute__((ext_vector_type(4)));
typedef float f32x16 __attribute__((ext_vector_type(16)));
typedef unsigned u32x2 __attribute__((ext_vector_type(2)));
typedef unsigned u32x4 __attribute__((ext_vector_type(4)));

constexpr int NTOK = 65536, TPROMPT = 32768, DM = 1024, DFF = 2816;
constexpr int NCU = 256, NTHR = 512;
constexpr float EPS = 1e-6f;
#ifndef XLO
#define XLO 0
#endif
constexpr int XLD = 2048;
constexpr int HID_LD = 2816, P_LD = 2048, C2_LD = 2048, QF_LD = 1536, K_LD = 192;
constexpr int LDS_STAGE = 131072, LDS_TOTAL = 163840, LDS_ST = 131072, LDS_TAB = 159488;

constexpr size_t SZ_FFN_IN = (size_t)5632 * 1024 * 2, SZ_FFN_OUT = (size_t)1024 * 2816 * 2;
constexpr size_t SL_F1I = 0, SL_F1O = SL_F1I + SZ_FFN_IN, SL_F2I = SL_F1O + SZ_FFN_OUT, SL_F2O = SL_F2I + SZ_FFN_IN, SL_MIX = SL_F2O + SZ_FFN_OUT;
constexpr size_t SG_IN = SL_MIX, SG_OUT = SG_IN + (size_t)3584 * 1024 * 2, SG_WS = SG_OUT + (size_t)1024 * 2048 * 2, SLOTA_SZ = SG_WS + (size_t)8 * 128 * 128 * 2;
constexpr size_t ML_IN = SL_MIX, ML_Q = ML_IN + (size_t)1024 * 1024 * 2, ML_OUT = ML_Q + (size_t)1536 * 256 * 2, SLOTB_SZ = ML_OUT + (size_t)1024 * 1536 * 2;
constexpr size_t WS_SLOTA = 0, WS_SLOTB = WS_SLOTA + SLOTA_SZ;
constexpr size_t WS_MEMW = WS_SLOTB + SLOTB_SZ;
constexpr size_t WS_MEMN = WS_MEMW + (size_t)4 * 1024 * 1024 * 2;
constexpr size_t WS_MEMKV = WS_MEMN + (size_t)1536 * 1024 * 2;
constexpr size_t WS_ROPE = WS_MEMKV + (size_t)4 * 1536 * 1024 * 2;
constexpr size_t WS_KBUF = WS_ROPE + (size_t)2 * 16384 * 32 * 4;
constexpr size_t WS_SCR = WS_KBUF + (size_t)NTOK * K_LD * 2;
constexpr size_t SLAB = (size_t)256 * P_LD * 2 + (size_t)2 * 1536 * 128 * 2;
constexpr size_t SCR_HID = 0;
constexpr size_t SCR_P = 0, SCR_VT = (size_t)256 * P_LD * 2;
constexpr size_t SCR_QF = 0, SCR_C2 = (size_t)256 * QF_LD * 2;
static_assert(SCR_C2 + (size_t)256 * C2_LD * 2 <= SLAB && (size_t)256 * HID_LD * 2 <= SLAB, "slab too small");
constexpr size_t SCR_SZ = SLAB * NCU;
constexpr size_t WS_BAR = WS_SCR + SCR_SZ;
constexpr size_t WS_END = WS_BAR + 256;

struct Params { const float* in[26]; float* out; unsigned char* ws; };

#define GAS __attribute__((address_space(1)))
template <class T> __device__ __forceinline__ T gld(const void* p) { return *(const GAS T*)p; }
template <class T> __device__ __forceinline__ void gst(void* p, T v) { *(GAS T*)p = v; }
template <class T> __device__ __forceinline__ T* as_global(T* p) { return (T*)(__attribute__((address_space(1))) T*)p; }
__device__ __forceinline__ unsigned cvtpk(float lo, float hi) { unsigned r; asm volatile("v_cvt_pk_bf16_f32 %0, %1, %2" : "=v"(r) : "v"(lo), "v"(hi)); return r; }
__device__ __forceinline__ float bflo(unsigned w) { return __uint_as_float(w << 16); }
__device__ __forceinline__ float bfhi(unsigned w) { return __uint_as_float(w & 0xffff0000u); }
__device__ __forceinline__ bf16_t f2bf(float f) { return (bf16_t)(cvtpk(f, f) & 0xffffu); }
__device__ __forceinline__ float silu_f(float g) { return g * __builtin_amdgcn_rcpf(1.f + __expf(-g)); }
__device__ __forceinline__ float gelu_f(float x) { const float z = 1.5957691216057308f * (x + 0.044715f * x * x * x); return x * __builtin_amdgcn_rcpf(1.f + __expf(-z)); }
__device__ __forceinline__ f32x4 gelu4(f32x4 a, float r) {
    const f32x4 v = a * r, q = v * v; f32x4 e = v * (q * -0.10294324f + -2.30220819f);
    e[0] = __builtin_amdgcn_exp2f(e[0]); e[1] = __builtin_amdgcn_exp2f(e[1]); e[2] = __builtin_amdgcn_exp2f(e[2]); e[3] = __builtin_amdgcn_exp2f(e[3]);
    f32x4 d = e + 1.0f;
    d[0] = __builtin_amdgcn_rcpf(d[0]); d[1] = __builtin_amdgcn_rcpf(d[1]); d[2] = __builtin_amdgcn_rcpf(d[2]); d[3] = __builtin_amdgcn_rcpf(d[3]);
    return v * d;
}
__device__ __forceinline__ float wave_sum(float v) {
#pragma unroll
    for (int o = 32; o > 0; o >>= 1) v += __shfl_xor(v, o, 64);
    return v;
}

constexpr int BK = 64, HALF = 128, HTB = HALF * BK * 2;
#ifndef SNAKE
#define SNAKE 1
#endif
__device__ __forceinline__ int lds_byte(int r, int c) { const int st = (r >> 4) * 2 + (c >> 5), rr = r & 15, cc = c & 31, ob = rr * 64 + cc * 2; return st * 1024 + (ob ^ (((ob >> 9) & 1) << 5)); }
__device__ __forceinline__ void stage_rc(int b, int& R, int& C) { const int st = b / 1024, sb = b % 1024, swz = sb ^ (((sb >> 9) & 1) << 5); R = (st >> 1) * 16 + swz / 64; C = (st & 1) * 32 + (swz % 64) / 2; }

struct GemmArgs { const bf16_t* A; size_t hstepA; int lda; const bf16_t* Bt; int K; int nN; };
typedef f32x4 Acc[2][2][4][2];

enum { EP_FFN1 = 0, EP_XUPD, EP_SGU_IN, EP_MLA_IN, EP_MLA_Q, EP_MEMKV };
struct Epi {
    int mode; int cu; float alpha; unsigned char* ws; float* out; float* st;

    __device__ __forceinline__ size_t grow(int ai, int rr) const { return (size_t)ai * TPROMPT + (size_t)cu * 128 + rr; }
    __device__ __forceinline__ size_t lrow(int ai, int rr) const { return (size_t)(ai * 128 + rr); }

    __device__ __forceinline__ void operator()(Acc& acc, int pn, int wr, int wc, int fr, int fq) const {
        asm volatile("" : "+v"(fr), "+v"(fq));
        unsigned char* const slab = ws + WS_SCR + (size_t)cu * SLAB;
        float* const st_rsx_ = st, *const st_rq_ = st + 512, *const st_xacc_ = st + 1024 + wc * 256, *const st_vacc_ = st + 2048 + wc * 256, *const st_qacc_ = st + 3072 + wc * 256;
        if (mode == EP_FFN1) {
            bf16_t* const o0 = (bf16_t*)(slab + SCR_HID); constexpr int ld0 = HID_LD; const float* const st_r = st_rsx_;
#pragma unroll
            for (int ai = 0; ai < 2; ++ai)
#pragma unroll
                for (int m = 0; m < 4; ++m) {
                    const int rr = wr * 64 + m * 16 + fr; const float r = st_r[ai * 128 + rr];
                    bf16_t* rowp = o0 + lrow(ai, rr) * (size_t)ld0 + pn * 128 + wc * 32 + fq * 8;
                    u32x4 w; const float c1 = -1.4426950408889634f * r, r2 = r * r;
#pragma unroll
                    for (int n = 0; n < 2; ++n) {
                        const f32x4 g = acc[ai][0][m][n], u = acc[ai][1][m][n];
                        f32x4 e = g * c1;
                        e[0] = __builtin_amdgcn_exp2f(e[0]); e[1] = __builtin_amdgcn_exp2f(e[1]); e[2] = __builtin_amdgcn_exp2f(e[2]); e[3] = __builtin_amdgcn_exp2f(e[3]);
                        f32x4 d = e + 1.0f;
                        d[0] = __builtin_amdgcn_rcpf(d[0]); d[1] = __builtin_amdgcn_rcpf(d[1]); d[2] = __builtin_amdgcn_rcpf(d[2]); d[3] = __builtin_amdgcn_rcpf(d[3]);
                        const f32x4 h = (g * u) * (d * r2);
                        w[2 * n] = cvtpk(h[0], h[1]); w[2 * n + 1] = cvtpk(h[2], h[3]);
                    }
                    gst<u32x4>(rowp, w);
                }
        } else if (mode == EP_XUPD) {
            bf16_t* const x = (bf16_t*)out; float* const st_acc = st_xacc_;
#pragma unroll
            for (int ai = 0; ai < 2; ++ai)
#pragma unroll
                for (int m = 0; m < 4; ++m) {
                    const int rr = wr * 64 + m * 16 + fr;
                    bf16_t* rowp = x + grow(ai, rr) * (size_t)XLD + pn * 256 + wc * 32 + fq * 8;
                    float ss = 0.f;
#pragma unroll
                    for (int bj = 0; bj < 2; ++bj) {
                        bf16_t* p = rowp + bj * 128;
                        const u32x4 h = gld<u32x4>(p); u32x4 l = {0u, 0u, 0u, 0u}; if (XLO) l = gld<u32x4>(p + 1024);
                        u32x4 nh, nl;
#pragma unroll
                        for (int n = 0; n < 2; ++n) {
                            const f32x4 a = acc[ai][bj][m][n];
                            const float x0 = bflo(h[2 * n]) + bflo(l[2 * n]) + alpha * a[0], x1 = bfhi(h[2 * n]) + bfhi(l[2 * n]) + alpha * a[1];
                            const float x2 = bflo(h[2 * n + 1]) + bflo(l[2 * n + 1]) + alpha * a[2], x3 = bfhi(h[2 * n + 1]) + bfhi(l[2 * n + 1]) + alpha * a[3];
                            ss += x0 * x0 + x1 * x1 + x2 * x2 + x3 * x3;
                            nh[2 * n] = cvtpk(x0, x1); nh[2 * n + 1] = cvtpk(x2, x3);
                            if (XLO) { nl[2 * n] = cvtpk(x0 - bflo(nh[2 * n]), x1 - bfhi(nh[2 * n])); nl[2 * n + 1] = cvtpk(x2 - bflo(nh[2 * n + 1]), x3 - bfhi(nh[2 * n + 1])); }
                        }
                        gst<u32x4>(p, nh); if (XLO) gst<u32x4>(p + 1024, nl);
                    }
                    ss += __shfl_xor(ss, 16, 64); ss += __shfl_xor(ss, 32, 64);
                    if (fq == 0) st_acc[ai * 128 + rr] += ss;
                }
        } else if (mode == EP_SGU_IN) {
            bf16_t* const o0 = (bf16_t*)(slab + SCR_P); constexpr int ld0 = P_LD; const float* const st_r = st_rsx_; float* const st_acc = st_vacc_;
            bf16_t* const vt = (bf16_t*)(slab + SCR_VT);
            if (pn < 8) {
#pragma unroll
                for (int ai = 0; ai < 2; ++ai)
#pragma unroll
                    for (int m = 0; m < 4; ++m) {
                        const int rr = wr * 64 + m * 16 + fr; const float r = st_r[ai * 128 + rr];
                        bf16_t* rowp = o0 + lrow(ai, rr) * (size_t)ld0 + pn * 256 + wc * 32 + fq * 8;
#pragma unroll
                        for (int bj = 0; bj < 2; ++bj) {
                            u32x4 w;
#pragma unroll
                            for (int n = 0; n < 2; ++n) {
                                const f32x4 v = (pn < 6) ? gelu4(acc[ai][bj][m][n], r) : acc[ai][bj][m][n] * r;
                                w[2 * n] = cvtpk(v[0], v[1]); w[2 * n + 1] = cvtpk(v[2], v[3]);
                            }
                            gst<u32x4>(rowp + bj * 128, w);
                        }
                    }
            } else {
#pragma unroll
                for (int ai = 0; ai < 2; ++ai)
#pragma unroll
                    for (int m = 0; m < 4; ++m) {
                        const int rr = wr * 64 + m * 16 + fr; const float r = st_r[ai * 128 + rr];
                        bf16_t* colp = vt + ((size_t)ai * 1536 + (size_t)(pn - 8) * 256 + wc * 32 + fq * 8) * 128 + rr;
                        float ss = 0.f;
#pragma unroll
                        for (int bj = 0; bj < 2; ++bj)
#pragma unroll
                            for (int n = 0; n < 2; ++n) {
                                const f32x4 gv = gelu4(acc[ai][bj][m][n], r);
#pragma unroll
                                for (int i = 0; i < 4; ++i) { const float v = gv[i]; ss += v * v; gst<bf16_t>(colp + (size_t)(bj * 128 + n * 4 + i) * 128, f2bf(v)); }
                            }
                        ss += __shfl_xor(ss, 16, 64); ss += __shfl_xor(ss, 32, 64);
                        if (fq == 0) st_acc[ai * 128 + rr] += ss;
                    }
            }
        } else if (mode == EP_MLA_IN) {
            bf16_t* const c2 = (bf16_t*)(slab + SCR_C2); bf16_t* const o0 = c2; constexpr int ld0 = C2_LD, ldkv = C2_LD / 2; float* const kvraw = (float*)(c2 + 256);
            const float* const st_r = st_rsx_; float* const st_acc = st_qacc_;
            if (pn == 0) {
#pragma unroll
                for (int ai = 0; ai < 2; ++ai)
#pragma unroll
                    for (int m = 0; m < 4; ++m) {
                        const int rr = wr * 64 + m * 16 + fr; const float r = st_r[ai * 128 + rr];
                        bf16_t* rowp = o0 + lrow(ai, rr) * (size_t)ld0 + wc * 32 + fq * 8;
                        float ss = 0.f;
#pragma unroll
                        for (int bj = 0; bj < 2; ++bj)
#pragma unroll
                            for (int n = 0; n < 2; ++n) {
                                const f32x4 v = acc[ai][bj][m][n] * r;
                                ss += v[0] * v[0] + v[1] * v[1] + v[2] * v[2] + v[3] * v[3];
                                u32x2 w; w[0] = cvtpk(v[0], v[1]); w[1] = cvtpk(v[2], v[3]);
                                gst<u32x2>(rowp + bj * 128 + n * 4, w);
                            }
                        ss += __shfl_xor(ss, 16, 64); ss += __shfl_xor(ss, 32, 64);
                        if (fq == 0) st_acc[ai * 128 + rr] += ss;
                        __builtin_amdgcn_sched_barrier(0);
                    }
            } else if (pn == 1) {
#pragma unroll
                for (int ai = 0; ai < 2; ++ai)
#pragma unroll
                    for (int m = 0; m < 4; ++m) {
                        const int rr = wr * 64 + m * 16 + fr; const float r = st_r[ai * 128 + rr];
                        float* rowp = kvraw + lrow(ai, rr) * (size_t)ldkv + wc * 32 + fq * 8;
#pragma unroll
                        for (int n = 0; n < 2; ++n) {
                            gst<f32x4>(rowp + n * 4, acc[ai][0][m][n] * r);
                            if (wc < 2) gst<f32x4>(rowp + 128 + n * 4, acc[ai][1][m][n] * r);
                        }
                        __builtin_amdgcn_sched_barrier(0);
                    }
            } else {
#pragma unroll
                for (int ai = 0; ai < 2; ++ai)
#pragma unroll
                    for (int m = 0; m < 4; ++m) {
                        const int rr = wr * 64 + m * 16 + fr; const float r = st_r[ai * 128 + rr];
                        bf16_t* rowp = c2 + lrow(ai, rr) * (size_t)C2_LD + 1024 + (pn - 2) * 256 + wc * 32 + fq * 8;
#pragma unroll
                        for (int bj = 0; bj < 2; ++bj)
#pragma unroll
                            for (int n = 0; n < 2; ++n) {
                                const f32x4 v = acc[ai][bj][m][n] * r;
                                u32x2 w; w[0] = cvtpk(v[0], v[1]); w[1] = cvtpk(v[2], v[3]);
                                gst<u32x2>(rowp + bj * 128 + n * 4, w);
                            }
                        __builtin_amdgcn_sched_barrier(0);
                    }
            }
        } else if (mode == EP_MLA_Q) {
            bf16_t* const o0 = (bf16_t*)(slab + SCR_QF); constexpr int ld0 = QF_LD; const float* const st_r = st_rq_;
            const float* const rcos = (const float*)(ws + WS_ROPE); const float* const rsin = rcos + 16384 * 32;
            if (pn < 4) {
#pragma unroll
                for (int ai = 0; ai < 2; ++ai)
#pragma unroll
                    for (int m = 0; m < 4; ++m) {
                        const int rr = wr * 64 + m * 16 + fr; const float r = st_r[ai * 128 + rr];
                        bf16_t* rowp = o0 + lrow(ai, rr) * (size_t)ld0 + 2 * pn * 192 + wc * 32 + fq * 8;
#pragma unroll
                        for (int bj = 0; bj < 2; ++bj)
#pragma unroll
                            for (int n = 0; n < 2; ++n) {
                                const f32x4 v = acc[ai][bj][m][n] * r;
                                u32x2 w; w[0] = cvtpk(v[0], v[1]); w[1] = cvtpk(v[2], v[3]);
                                gst<u32x2>(rowp + bj * 192 + n * 4, w);
                            }
                        __builtin_amdgcn_sched_barrier(0);
                    }
            } else {
#pragma unroll
                for (int ai = 0; ai < 2; ++ai)
#pragma unroll
                    for (int m = 0; m < 4; ++m) {
                        const int rr = wr * 64 + m * 16 + fr; const float r = st_r[ai * 128 + rr];
                        const int pos = (cu * 128 + rr) & (ai ? 16383 : 8191);
                        bf16_t* rowp = o0 + lrow(ai, rr) * (size_t)ld0 + (4 * (pn - 4) + wc) * 192 + 128 + fq * 8;
                        const float* cp = rcos + pos * 32 + fq * 8; const float* sp = rsin + pos * 32 + fq * 8;
#pragma unroll
                        for (int n = 0; n < 2; ++n) {
                            const f32x4 c = gld<f32x4>(cp + n * 4), s = gld<f32x4>(sp + n * 4);
                            const f32x4 x1 = acc[ai][0][m][n] * r, x2 = acc[ai][1][m][n] * r;
                            const f32x4 y1 = x1 * c - x2 * s, y2 = x1 * s + x2 * c;
                            u32x2 w1, w2; w1[0] = cvtpk(y1[0], y1[1]); w1[1] = cvtpk(y1[2], y1[3]); w2[0] = cvtpk(y2[0], y2[1]); w2[1] = cvtpk(y2[2], y2[3]);
                            gst<u32x2>(rowp + n * 4, w1); gst<u32x2>(rowp + 32 + n * 4, w2);
                        }
                        __builtin_amdgcn_sched_barrier(0);
                    }
            }
        } else {
            const int pn0 = cu & 3; constexpr int ld0 = 1024;
            bf16_t* const o0 = (bf16_t*)(ws + WS_MEMKV) + ((size_t)(cu / 24) * 1536 + ((cu % 24) >> 2) * 256) * 1024;
#pragma unroll
            for (int ai = 0; ai < 2; ++ai)
#pragma unroll
                for (int m = 0; m < 4; ++m) {
                    bf16_t* rowp = o0 + (size_t)(ai * 128 + wr * 64 + m * 16 + fr) * ld0 + pn0 * 256 + wc * 32 + fq * 8;
#pragma unroll
                    for (int bj = 0; bj < 2; ++bj)
#pragma unroll
                        for (int n = 0; n < 2; ++n) {
                            const f32x4 v = acc[ai][bj][m][n];
                            u32x2 w; w[0] = cvtpk(v[0], v[1]); w[1] = cvtpk(v[2], v[3]);
                            gst<u32x2>(rowp + bj * 128 + n * 4, w);
                        }
                }
        }
    }
};

__device__ __forceinline__ void gemm_phase(LAS unsigned char* lds, const GemmArgs g, const Epi& E, const int tid) {
    const int wid = __builtin_amdgcn_readfirstlane(tid >> 6), lane = tid & 63, wr = wid >> 2, wc = wid & 3, fr = lane & 15, fq = lane >> 4;
    const int K = g.K, nt = K / BK;
    unsigned voffA[2], voffB[2];
#pragma unroll
    for (int i = 0; i < 2; ++i) { int R, C; stage_rc(tid * 16 + i * 8192, R, C); const int rho = R & 31, Rb = (R & ~31) + 8 * ((rho & 15) >> 2) + 4 * (rho >> 4) + (rho & 3);
        voffA[i] = (unsigned)(R * g.lda + C) * 2u; voffB[i] = (unsigned)(Rb * K + C) * 2u; }
    const size_t kstep = (size_t)(BK * 2);
    const size_t hstepB = (size_t)HALF * K * 2, tstepB = 2 * hstepB, hstepA = g.hstepA;
    const unsigned ldsw = (unsigned)wid * 1024u;
    const int aoff = lds_byte(wr * 64 + fr, fq * 8), boff = lds_byte(wc * 32 + fr, fq * 8);
#define PG8_SA(b, h) (((b) * 2 + (h)) * HTB)
#define PG8_SB(b, h) ((4 + (b) * 2 + (h)) * HTB)
#define PG8_STAGE(bufoff, gbase, voff) do { _Pragma("unroll") for (int _i = 0; _i < 2; ++_i) \
        __builtin_amdgcn_global_load_lds((const unsigned*)((const char*)(gbase) + (voff)[_i]), (LAS unsigned*)(lds + (bufoff) + ldsw + _i * 8192), 16, 0, 0); } while (0)
#define PG8_LDA(dst, b, h) do { _Pragma("unroll") for (int m = 0; m < 4; ++m) _Pragma("unroll") for (int k = 0; k < 2; ++k) dst[m][k] = *(const LAS bf16x8*)(lds + PG8_SA(b, h) + aoff + m * 2048 + k * 1024); } while (0)
#define PG8_LDB(dst, b, h) do { _Pragma("unroll") for (int n = 0; n < 2; ++n) _Pragma("unroll") for (int k = 0; k < 2; ++k) dst[n][k] = *(const LAS bf16x8*)(lds + PG8_SB(b, h) + boff + n * 2048 + k * 1024); } while (0)
#define PG8_MMA(ai, bj, At, Bt) do { __builtin_amdgcn_s_setprio(1); _Pragma("unroll") for (int m = 0; m < 4; ++m) _Pragma("unroll") for (int n = 0; n < 2; ++n) _Pragma("unroll") for (int k = 0; k < 2; ++k) \
        acc[ai][bj][m][n] = __builtin_amdgcn_mfma_f32_16x16x32_bf16(Bt[n][k], At[m][k], acc[ai][bj][m][n], 0, 0, 0); __builtin_amdgcn_s_setprio(0); } while (0)
#define PG8_WAIT_V(n) asm volatile("s_waitcnt vmcnt(" #n ")" ::: "memory")
#define PG8_WAIT_L(n) asm volatile("s_waitcnt lgkmcnt(" #n ")" ::: "memory")
#define PG8_BAR __builtin_amdgcn_s_barrier()
#define PG8_SCHED __builtin_amdgcn_sched_barrier(0)
    int ui = 0;
    Acc acc;
#pragma unroll
    for (int a = 0; a < 2; ++a)
#pragma unroll
        for (int b = 0; b < 2; ++b)
#pragma unroll
            for (int m = 0; m < 4; ++m)
#pragma unroll
                for (int n = 0; n < 2; ++n) acc[a][b][m][n] = (f32x4){0.f, 0.f, 0.f, 0.f};
    bf16x8 At[4][2], B0[2][2], B1[2][2];
    const ptrdiff_t KS = (ptrdiff_t)(BK * 2), lastoff = (ptrdiff_t)(nt - 1) * KS;
    const char* cA = (const char*)g.A; const char* cB = (const char*)g.Bt; ptrdiff_t ks = KS;
    PG8_STAGE(PG8_SB(0, 0), cB, voffB); PG8_STAGE(PG8_SA(0, 0), cA, voffA); PG8_STAGE(PG8_SB(0, 1), cB + hstepB, voffB); PG8_STAGE(PG8_SA(0, 1), cA + hstepA, voffA);
    if (wr == 1) PG8_BAR;
    PG8_WAIT_V(4); PG8_BAR;
    PG8_STAGE(PG8_SB(1, 0), cB + kstep, voffB); PG8_STAGE(PG8_SA(1, 0), cA + kstep, voffA); PG8_STAGE(PG8_SB(1, 1), cB + hstepB + kstep, voffB);
    PG8_WAIT_V(6); PG8_BAR;
    for (;;) {
        const bool has_next = (ui + 1 < g.nN);
        const bool nrev = SNAKE && (((ui + 1) & 1) != 0);
        const char* nA = has_next ? (const char*)g.A + (nrev ? lastoff : 0) : cA;
        const char* nB = has_next ? (const char*)g.Bt + (size_t)(ui + 1) * tstepB + (nrev ? lastoff : 0) : cB;
        const ptrdiff_t nks = has_next ? (nrev ? -KS : KS) : ks;
        for (int t = 0; t < nt; t += 2) {
            const bool last = (t == nt - 2);
            const char* a1 = cA + (ptrdiff_t)(t + 1) * ks;
            const char* a2 = last ? nA : cA + (ptrdiff_t)(t + 2) * ks; const char* b2 = last ? nB : cB + (ptrdiff_t)(t + 2) * ks;
            const ptrdiff_t k3 = last ? nks : ks;
            const char* a3 = a2 + k3; const char* b3 = b2 + k3;
            PG8_LDB(B0, 0, 0); PG8_SCHED; PG8_LDA(At, 0, 0); PG8_STAGE(PG8_SA(1, 1), a1 + hstepA, voffA);
            PG8_WAIT_L(8); PG8_BAR; PG8_WAIT_L(0); PG8_MMA(0, 0, At, B0); PG8_BAR; PG8_SCHED;
            PG8_LDB(B1, 0, 1); PG8_STAGE(PG8_SB(0, 0), b2, voffB);
            PG8_BAR; PG8_WAIT_L(0); PG8_MMA(0, 1, At, B1); PG8_BAR;
            PG8_LDA(At, 0, 1); PG8_STAGE(PG8_SA(0, 0), a2, voffA);
            PG8_BAR; PG8_WAIT_L(0); PG8_MMA(1, 0, At, B0); PG8_BAR; PG8_SCHED;
            PG8_STAGE(PG8_SB(0, 1), b2 + hstepB, voffB);
            PG8_WAIT_V(6); PG8_BAR; PG8_MMA(1, 1, At, B1); PG8_BAR;
            PG8_LDB(B0, 1, 0); PG8_SCHED; PG8_LDA(At, 1, 0); PG8_STAGE(PG8_SA(0, 1), a2 + hstepA, voffA);
            PG8_WAIT_L(8); PG8_BAR; PG8_WAIT_L(0); PG8_MMA(0, 0, At, B0); PG8_BAR; PG8_SCHED;
            PG8_LDB(B1, 1, 1); PG8_STAGE(PG8_SB(1, 0), b3, voffB);
            PG8_BAR; PG8_WAIT_L(0); PG8_MMA(0, 1, At, B1); PG8_BAR;
            PG8_LDA(At, 1, 1); PG8_STAGE(PG8_SA(1, 0), a3, voffA);
            PG8_BAR; PG8_WAIT_L(0); PG8_MMA(1, 0, At, B0); PG8_BAR; PG8_SCHED;
            PG8_STAGE(PG8_SB(1, 1), b3 + hstepB, voffB);
            PG8_WAIT_V(6); PG8_BAR; PG8_MMA(1, 1, At, B1); PG8_BAR;
        }
        E(acc, ui, wr, wc, fr, fq);
        if (!has_next) break;
#pragma unroll
        for (int a = 0; a < 2; ++a)
#pragma unroll
            for (int b = 0; b < 2; ++b)
#pragma unroll
                for (int m = 0; m < 4; ++m)
#pragma unroll
                    for (int n = 0; n < 2; ++n) acc[a][b][m][n] = (f32x4){0.f, 0.f, 0.f, 0.f};
        cA = nA; cB = nB; ks = nks; ++ui;
    }
    PG8_WAIT_V(0);
    if (wr == 0) PG8_BAR;
    PG8_BAR;
#undef PG8_SA
#undef PG8_SB
#undef PG8_STAGE
#undef PG8_LDA
#undef PG8_LDB
#undef PG8_MMA
#undef PG8_WAIT_V
#undef PG8_WAIT_L
#undef PG8_BAR
#undef PG8_SCHED
    __syncthreads();
}

#define KSWZ(row, colB) ((row) * 256 + ((colB) ^ (((row) & 15) << 4)))
#define KRSWZ(row, colB) ((row) * 128 + ((colB) ^ ((((row) >> 1) & 7) << 4)))
#define SBAR() __builtin_amdgcn_sched_barrier(0)
constexpr float ATT_THR = 8.f;
constexpr int SHM_V = 64 * 128 * 2, SHM_K = 64 * 128 * 2, SHM_KR = 64 * 64 * 2;
constexpr int AL_V = 0, AL_K = 2 * SHM_V, AL_KR = AL_K + 2 * SHM_K, AL_WS = AL_KR + 2 * SHM_KR, AL_Q = AL_WS + 2048;
#ifndef MLA_DMA
#define MLA_DMA 1
#endif
#ifndef MLA_NQL
#define MLA_NQL 4
#endif
#ifndef MLA_SD
#define MLA_SD 1
#endif
constexpr int NQL = MLA_NQL;
static_assert(AL_Q + 8 * NQL * 1024 <= LDS_TAB, "attention LDS overflows into the statistics");
__device__ __forceinline__ int crow(int r, int hi) { return (r & 3) + 8 * (r >> 2) + 4 * hi; }

template <bool MLA> __device__ __forceinline__ void partialSM(f32x16& p0, f32x16& p1, float& m_reg, float& mn, float& alpha) {
    constexpr float SCALE = MLA ? 1.0f : 0.088388347648318440f;
    constexpr float C = SCALE * 1.4426950408889634f;
    float pmax = p0[0];
#pragma unroll
    for (int r = 1; r < 16; ++r) pmax = fmaxf(pmax, p0[r]);
#pragma unroll
    for (int r = 0; r < 16; ++r) pmax = fmaxf(pmax, p1[r]);
    { auto rr = __builtin_amdgcn_permlane32_swap(__float_as_uint(pmax), __float_as_uint(pmax), false, false);
      pmax = fmaxf(__uint_as_float(rr[0]), __uint_as_float(rr[1])); }
    if (__builtin_expect(__all(pmax - m_reg <= ATT_THR / SCALE), 1)) { mn = m_reg; alpha = 1.f; }
    else { mn = fmaxf(m_reg, pmax); alpha = __builtin_amdgcn_exp2f((m_reg - mn) * C); m_reg = mn; }
    const float mnC = -mn * C;
#pragma unroll
    for (int r = 0; r < 16; ++r) p0[r] = fmaf(p0[r], C, mnC);
#pragma unroll
    for (int r = 0; r < 16; ++r) p1[r] = fmaf(p1[r], C, mnC);
#pragma unroll
    for (int r = 0; r < 16; ++r) p0[r] = __builtin_amdgcn_exp2f(p0[r]);
}
__device__ __forceinline__ void finishSM(f32x16& p0, f32x16& p1, float alpha, float& l_reg, bf16x8& pa0, bf16x8& pa1, bf16x8& pa2, bf16x8& pa3) {
#pragma unroll
    for (int r = 0; r < 16; ++r) p1[r] = __builtin_amdgcn_exp2f(p1[r]);
    float ps = 0;
#pragma unroll
    for (int r = 0; r < 16; ++r) ps += p0[r];
#pragma unroll
    for (int r = 0; r < 16; ++r) ps += p1[r];
    { auto rr = __builtin_amdgcn_permlane32_swap(__float_as_uint(ps), __float_as_uint(ps), false, false);
      ps = __uint_as_float(rr[0]) + __uint_as_float(rr[1]); }
    l_reg = l_reg * alpha + ps;
#define PK4(P, BASE, OUT) do { unsigned a0 = cvtpk(P[BASE + 0], P[BASE + 1]), a1 = cvtpk(P[BASE + 2], P[BASE + 3]);   \
    unsigned b0 = cvtpk(P[BASE + 4], P[BASE + 5]), b1 = cvtpk(P[BASE + 6], P[BASE + 7]);                              \
    auto r0 = __builtin_amdgcn_permlane32_swap(a0, b0, false, false); auto r1 = __builtin_amdgcn_permlane32_swap(a1, b1, false, false); \
    u32x4 w = {r0[0], r1[0], r0[1], r1[1]}; OUT = *reinterpret_cast<bf16x8*>(&w); } while (0)
    PK4(p0, 0, pa0); PK4(p0, 8, pa1); PK4(p1, 0, pa2); PK4(p1, 8, pa3);
#undef PK4
}
template <bool MLA> __device__ __forceinline__ void qkt(f32x16& p0, f32x16& p1, const char* Ks, const char* KRs, const bf16x8* qr, const char* ql, int r32, int hi) {
    p0 = f32x16{}; p1 = f32x16{};
#pragma unroll
    for (int d0 = 0; d0 < 8; ++d0) { const int cb = (d0 * 16 + hi * 8) * 2;
        const bf16x8 b0 = *reinterpret_cast<const bf16x8*>(Ks + KSWZ(r32, cb));
        const bf16x8 b1 = *reinterpret_cast<const bf16x8*>(Ks + KSWZ(32 + r32, cb));
        const bf16x8 qq = (MLA && d0 >= 12 - NQL) ? *reinterpret_cast<const bf16x8*>(ql + (d0 - (12 - NQL)) * 1024) : qr[(MLA && d0 >= 12 - NQL) ? 0 : d0];
        p0 = __builtin_amdgcn_mfma_f32_32x32x16_bf16(b0, qq, p0, 0, 0, 0);
        p1 = __builtin_amdgcn_mfma_f32_32x32x16_bf16(b1, qq, p1, 0, 0, 0); }
    if constexpr (MLA) {
#pragma unroll
        for (int d0 = 0; d0 < 4; ++d0) { const int cb = (d0 * 16 + hi * 8) * 2;
            const bf16x8 b0 = *reinterpret_cast<const bf16x8*>(KRs + KRSWZ(r32, cb));
            const bf16x8 b1 = *reinterpret_cast<const bf16x8*>(KRs + KRSWZ(32 + r32, cb));
            const bf16x8 qq = (8 + d0 >= 12 - NQL) ? *reinterpret_cast<const bf16x8*>(ql + (8 + d0 - (12 - NQL)) * 1024) : qr[(8 + d0 >= 12 - NQL) ? 0 : 8 + d0];
            p0 = __builtin_amdgcn_mfma_f32_32x32x16_bf16(b0, qq, p0, 0, 0, 0);
            p1 = __builtin_amdgcn_mfma_f32_32x32x16_bf16(b1, qq, p1, 0, 0, 0); }
    }
}
__device__ __forceinline__ int v_st(int k, int c) { const int kk = (k & ~0xC) | ((k & 4) << 1) | ((k & 8) >> 1); return ((kk >> 3) * 4 + (c >> 5)) * 512 + ((kk & 7) * 32 + (c & 31)) * 2; }
__device__ __forceinline__ int v_rd_base(int lane) { return ((lane & 3) << 3) | (((lane >> 2) & 3) << 6) | (((lane >> 4) & 1) << 5) | (((lane >> 5) & 1) << 8); }
constexpr int v_rd_off(int d0, int ks, int half) { return d0 * 512 + ks * 4096 + half * 2048; }
template <int OFF> __device__ __forceinline__ s16x4 tr_read(int vb) {
    s16x4 r; asm volatile("ds_read_b64_tr_b16 %0, %1 offset:%2" : "=&v"(r) : "v"(vb), "i"(OFF) : "memory"); return r;
}
template <int D0> __device__ __forceinline__ void pv_one(f32x16& od, int vb, bf16x8 pa0, bf16x8 pa1, bf16x8 pa2, bf16x8 pa3) {
    const s16x4 l0 = tr_read<v_rd_off(D0, 0, 0)>(vb), h0 = tr_read<v_rd_off(D0, 0, 1)>(vb), l1 = tr_read<v_rd_off(D0, 1, 0)>(vb), h1 = tr_read<v_rd_off(D0, 1, 1)>(vb);
    const s16x4 l2 = tr_read<v_rd_off(D0, 2, 0)>(vb), h2 = tr_read<v_rd_off(D0, 2, 1)>(vb), l3 = tr_read<v_rd_off(D0, 3, 0)>(vb), h3 = tr_read<v_rd_off(D0, 3, 1)>(vb);
    asm volatile("s_waitcnt lgkmcnt(0)" ::: "memory"); SBAR();
#define PK(L, H) (bf16x8){L[0], L[1], L[2], L[3], H[0], H[1], H[2], H[3]}
    od = __builtin_amdgcn_mfma_f32_32x32x16_bf16(pa0, PK(l0, h0), od, 0, 0, 0);
    od = __builtin_amdgcn_mfma_f32_32x32x16_bf16(pa1, PK(l1, h1), od, 0, 0, 0);
    od = __builtin_amdgcn_mfma_f32_32x32x16_bf16(pa2, PK(l2, h2), od, 0, 0, 0);
    od = __builtin_amdgcn_mfma_f32_32x32x16_bf16(pa3, PK(l3, h3), od, 0, 0, 0);
#undef PK
}
__device__ __forceinline__ void pv_d0(f32x16* o, int vb, bf16x8 pa0, bf16x8 pa1, bf16x8 pa2, bf16x8 pa3) {
    pv_one<0>(o[0], vb, pa0, pa1, pa2, pa3); pv_one<1>(o[1], vb, pa0, pa1, pa2, pa3); pv_one<2>(o[2], vb, pa0, pa1, pa2, pa3); pv_one<3>(o[3], vb, pa0, pa1, pa2, pa3);
}

template <bool MLA, int ldq, int ldk, int ldo>
__device__ __forceinline__ void attn_body(const bf16_t* __restrict__ Qw, const bf16_t* __restrict__ Kg, const bf16_t* __restrict__ Vg, int seq,
                                          bf16_t* __restrict__ Ow, bool do_store, char* lds, const int tid) {
    constexpr int NQ = MLA ? 12 - NQL : 8;
    const int wid = tid >> 6, lane = tid & 63, r32 = lane & 31, hi = lane >> 5;
    char* V_lds = lds + AL_V; char* K_lds = lds + AL_K; char* KR_lds = lds + AL_KR;
    float* ws = (float*)(lds + AL_WS) + wid * 64; float* li_l = ws; float* al_l = ws + 32;
    float m_reg = -1e30f, l_reg = 0; f32x16 o[4] = {}; bf16x8 qr[NQ];
    const bf16_t* Ql = Qw + (size_t)r32 * ldq + hi * 8;
#pragma unroll
    for (int d0 = 0; d0 < NQ; ++d0) qr[d0] = gld<bf16x8>(Ql + d0 * 16);
    const char* ql = lds + AL_Q + wid * (NQL * 1024) + lane * 16;
    if constexpr (MLA) {
#pragma unroll
        for (int d0 = NQ; d0 < 12; ++d0) *(bf16x8*)(lds + AL_Q + wid * (NQL * 1024) + (d0 - NQ) * 1024 + lane * 16) = gld<bf16x8>(Ql + d0 * 16);
    }
    const int sr = tid >> 4, sc = (tid & 15) * 8, vst0 = v_st(sr, sc), vst1 = v_st(32 + sr, sc);
    const int rr_ = tid >> 3, rc_ = (tid & 7) * 8;
    const int vb0 = (int)(uintptr_t)V_lds + v_rd_base(lane);
    constexpr int SD = MLA ? MLA_SD : 2;
    struct { bf16x8 vs0, vs1, ks0, ks1; } sr_[SD];
#define SLOAD(i, k0) do { if constexpr (MLA) { \
        sr_[i].ks0 = gld<bf16x8>(&Kg[(size_t)((k0) + sr) * ldk + sc]); sr_[i].ks1 = gld<bf16x8>(&Kg[(size_t)((k0) + 32 + sr) * ldk + sc]); \
        sr_[i].vs0 = gld<bf16x8>(&Kg[(size_t)((k0) + rr_) * ldk + 128 + rc_]); \
    } else { \
        sr_[i].vs0 = gld<bf16x8>(&Vg[(size_t)((k0) + sr) * ldk + sc]); sr_[i].vs1 = gld<bf16x8>(&Vg[(size_t)((k0) + 32 + sr) * ldk + sc]); \
        sr_[i].ks0 = gld<bf16x8>(&Kg[(size_t)((k0) + sr) * ldk + sc]); sr_[i].ks1 = gld<bf16x8>(&Kg[(size_t)((k0) + 32 + sr) * ldk + sc]); } } while (0)
#define SWRITE(b, i) do { const int kc = sc * 2; if constexpr (MLA) { \
        *(bf16x8*)(V_lds + (b) * SHM_V + vst0) = sr_[i].ks0; *(bf16x8*)(V_lds + (b) * SHM_V + vst1) = sr_[i].ks1; \
        *(bf16x8*)(KR_lds + (b) * SHM_KR + KRSWZ(rr_, rc_ * 2)) = sr_[i].vs0; \
    } else { \
        *(bf16x8*)(V_lds + (b) * SHM_V + vst0) = sr_[i].vs0; *(bf16x8*)(V_lds + (b) * SHM_V + vst1) = sr_[i].vs1; } \
        *(bf16x8*)(K_lds + (b) * SHM_K + KSWZ(sr, kc)) = sr_[i].ks0; *(bf16x8*)(K_lds + (b) * SHM_K + KSWZ(32 + sr, kc)) = sr_[i].ks1; } while (0)
#define SWAIT() do { if constexpr (SD == 1) asm volatile("s_waitcnt vmcnt(0)" ::: "memory"); else if constexpr (MLA) asm volatile("s_waitcnt vmcnt(3)" ::: "memory"); else asm volatile("s_waitcnt vmcnt(4)" ::: "memory"); } while (0)
#define RESC(a) do { if (__any((a) < 1.f)) { if (hi == 0) al_l[r32] = (a); asm volatile("s_waitcnt lgkmcnt(0)" ::: "memory"); \
    _Pragma("unroll") for (int d = 0; d < 4; ++d) _Pragma("unroll") for (int r = 0; r < 16; ++r) o[d][r] *= al_l[crow(r, hi)]; } } while (0)
    f32x16 pA0, pA1, pB0, pB1; float mnA, mnB, alA, alB; bf16x8 pa0, pa1, pa2, pa3; const int NT = seq / 64;
    constexpr int SE = 0, SO = SD - 1;
    SLOAD(SE, 0); asm volatile("s_waitcnt vmcnt(0)" ::: "memory"); SWRITE(0, SE); __syncthreads();
    qkt<MLA>(pA0, pA1, K_lds, KR_lds, qr, ql, r32, hi); partialSM<MLA>(pA0, pA1, m_reg, mnA, alA);
    SLOAD(SO, 64); if constexpr (SD == 2) { if (2 < NT) SLOAD(SE, 128); }
    SWAIT(); SWRITE(1, SO); __syncthreads();
    for (int j = 1; j + 1 < NT; j += 2) {
        SBAR(); qkt<MLA>(pB0, pB1, K_lds + SHM_K, KR_lds + SHM_KR, qr, ql, r32, hi);
        finishSM(pA0, pA1, alA, l_reg, pa0, pa1, pa2, pa3); SBAR();
        SLOAD(SO, (j + SD) * 64); SBAR();
        pv_d0(o, vb0, pa0, pa1, pa2, pa3); partialSM<MLA>(pB0, pB1, m_reg, mnB, alB);
        __syncthreads(); SWAIT(); SWRITE(0, SE);
        RESC(alB); __syncthreads();
        SBAR(); qkt<MLA>(pA0, pA1, K_lds, KR_lds, qr, ql, r32, hi);
        finishSM(pB0, pB1, alB, l_reg, pa0, pa1, pa2, pa3); SBAR();
        if (SD == 1 || j + 3 < NT) SLOAD(SE, (j + 1 + SD) * 64); SBAR();
        pv_d0(o, vb0 + SHM_V, pa0, pa1, pa2, pa3); partialSM<MLA>(pA0, pA1, m_reg, mnA, alA);
        __syncthreads(); SWAIT(); SWRITE(1, SO);
        RESC(alA); __syncthreads();
    }
    SBAR(); qkt<MLA>(pB0, pB1, K_lds + SHM_K, KR_lds + SHM_KR, qr, ql, r32, hi);
    finishSM(pA0, pA1, alA, l_reg, pa0, pa1, pa2, pa3); SBAR();
    pv_d0(o, vb0, pa0, pa1, pa2, pa3); partialSM<MLA>(pB0, pB1, m_reg, mnB, alB);
    __syncthreads(); RESC(alB);
    finishSM(pB0, pB1, alB, l_reg, pa0, pa1, pa2, pa3); SBAR();
    pv_d0(o, vb0 + SHM_V, pa0, pa1, pa2, pa3);
    if (hi == 0) li_l[r32] = l_reg; asm volatile("s_waitcnt lgkmcnt(0)" ::: "memory");
    float rli[16];
#pragma unroll
    for (int r = 0; r < 16; ++r) rli[r] = __builtin_amdgcn_rcpf(li_l[crow(r, hi)]);
    if (do_store) {
#pragma unroll
        for (int r = 0; r < 16; ++r) { const int orow = crow(r, hi);
#pragma unroll
            for (int d0 = 0; d0 < 4; ++d0) gst<bf16_t>(Ow + (size_t)orow * ldo + d0 * 32 + r32, f2bf(o[d0][r] * rli[r])); }
    }
    __syncthreads();
#undef SLOAD
#undef SWRITE
#undef SWAIT
#undef RESC
}


constexpr int TB3 = 40960, AL3_WS = 3 * TB3;
static_assert(AL3_WS + 2048 <= LDS_ST, "DMA attention ring overflows into the statistics");
__device__ __forceinline__ void qkt12(f32x16& p0, f32x16& p1, const char* Ks, const char* KRs, const bf16x8* qr, int r32, int hi) {
    p0 = f32x16{}; p1 = f32x16{};
#pragma unroll
    for (int d0 = 0; d0 < 8; ++d0) { const int cb = (d0 * 16 + hi * 8) * 2;
        const bf16x8 b0 = *reinterpret_cast<const bf16x8*>(Ks + KSWZ(r32, cb));
        const bf16x8 b1 = *reinterpret_cast<const bf16x8*>(Ks + KSWZ(32 + r32, cb));
        p0 = __builtin_amdgcn_mfma_f32_32x32x16_bf16(b0, qr[d0], p0, 0, 0, 0);
        p1 = __builtin_amdgcn_mfma_f32_32x32x16_bf16(b1, qr[d0], p1, 0, 0, 0); }
#pragma unroll
    for (int d0 = 0; d0 < 4; ++d0) { const int cb = (d0 * 16 + hi * 8) * 2;
        const bf16x8 b0 = *reinterpret_cast<const bf16x8*>(KRs + KRSWZ(r32, cb));
        const bf16x8 b1 = *reinterpret_cast<const bf16x8*>(KRs + KRSWZ(32 + r32, cb));
        p0 = __builtin_amdgcn_mfma_f32_32x32x16_bf16(b0, qr[8 + d0], p0, 0, 0, 0);
        p1 = __builtin_amdgcn_mfma_f32_32x32x16_bf16(b1, qr[8 + d0], p1, 0, 0, 0); }
}
template <bool MLA, int ldq, int ldk, int ldo>
__device__ __forceinline__ void attn_dma(const bf16_t* __restrict__ Qw, const bf16_t* __restrict__ Kg, const bf16_t* __restrict__ Vg, int seq, bf16_t* __restrict__ Ow, bool do_store, char* lds, const int tid) {
    constexpr int RB = ldk * 2, NQ = MLA ? 12 : 8;
    const int wid = __builtin_amdgcn_readfirstlane(tid >> 6), lane = tid & 63, r32 = lane & 31, hi = lane >> 5;
    float* ws = (float*)(lds + AL3_WS) + wid * 64; float* li_l = ws; float* al_l = ws + 32;
    float m_reg = -1e30f, l_reg = 0; f32x16 o[4] = {}; bf16x8 qr[NQ];
    const bf16_t* Ql = Qw + (size_t)r32 * ldq + hi * 8;
#pragma unroll
    for (int d0 = 0; d0 < NQ; ++d0) qr[d0] = gld<bf16x8>(Ql + d0 * 16);
    unsigned voffK, voffV, voffR;
    { const int G = wid * 64 + lane, row = G >> 4, sl = G & 15; voffK = (unsigned)(row * RB + ((sl ^ (row & 15)) * 16)); }
    { const int G = wid * 64 + lane, sub = G >> 5, r = G & 31, kk = (sub >> 2) * 8 + (r >> 2), k = (kk & ~0xC) | ((kk & 4) << 1) | ((kk & 8) >> 1), c = (sub & 3) * 32 + (r & 3) * 8;
      voffV = (unsigned)(k * RB + c * 2); }
    { const int G = wid * 64 + lane, row = G >> 3, sl = G & 7; voffR = (unsigned)(row * RB + 256 + ((sl ^ ((row >> 1) & 7)) * 16)); }
    const int vrd = v_rd_base(lane);
    LAS unsigned char* ldsl = (LAS unsigned char*)lds;
#define DMA3(boff, t) do { const char* _tb = (const char*)Kg + (size_t)(t) * (64 * RB); const char* _tv = MLA ? _tb : (const char*)Vg + (size_t)(t) * (64 * RB); LAS unsigned char* _lb = ldsl + (boff) + wid * 1024; \
        __builtin_amdgcn_global_load_lds((const unsigned*)(_tb + voffK), (LAS unsigned*)(_lb), 16, 0, 0); \
        __builtin_amdgcn_global_load_lds((const unsigned*)(_tb + 32 * RB + voffK), (LAS unsigned*)(_lb + 8192), 16, 0, 0); \
        __builtin_amdgcn_global_load_lds((const unsigned*)(_tv + voffV), (LAS unsigned*)(_lb + 16384), 16, 0, 0); \
        __builtin_amdgcn_global_load_lds((const unsigned*)(_tv + 32 * RB + voffV), (LAS unsigned*)(_lb + 24576), 16, 0, 0); \
        if constexpr (MLA) __builtin_amdgcn_global_load_lds((const unsigned*)(_tb + voffR), (LAS unsigned*)(_lb + 32768), 16, 0, 0); } while (0)
#define QKT3(P0, P1, boff) do { if constexpr (MLA) qkt12(P0, P1, lds + (boff), lds + (boff) + 32768, qr, r32, hi); else qkt<false>(P0, P1, lds + (boff), nullptr, qr, nullptr, r32, hi); } while (0)
#define RESC3(a) do { if (__any((a) < 1.f)) { if (hi == 0) al_l[r32] = (a); asm volatile("s_waitcnt lgkmcnt(0)" ::: "memory"); \
    _Pragma("unroll") for (int d = 0; d < 4; ++d) _Pragma("unroll") for (int r = 0; r < 16; ++r) o[d][r] *= al_l[crow(r, hi)]; } } while (0)
#define VB3(boff) ((int)(uintptr_t)(lds + (boff) + 16384) + vrd)
    f32x16 pA0, pA1, pB0, pB1; float mnA, mnB, alA, alB; bf16x8 pa0, pa1, pa2, pa3; const int NT = seq / 64;
    int bp = 0, bc = TB3, bn = 2 * TB3;
    DMA3(0, 0); DMA3(TB3, 1);
    asm volatile("s_waitcnt vmcnt(0)" ::: "memory"); __syncthreads();
    QKT3(pA0, pA1, 0); partialSM<MLA>(pA0, pA1, m_reg, mnA, alA);
    for (int j = 1; j + 1 < NT; j += 2) {
        DMA3(bn, j + 1);
        QKT3(pB0, pB1, bc);
        finishSM(pA0, pA1, alA, l_reg, pa0, pa1, pa2, pa3);
        pv_d0(o, VB3(bp), pa0, pa1, pa2, pa3); partialSM<MLA>(pB0, pB1, m_reg, mnB, alB);
        asm volatile("s_waitcnt vmcnt(0)" ::: "memory"); __syncthreads();
        RESC3(alB);
        { const int t_ = bp; bp = bc; bc = bn; bn = t_; }
        if (j + 2 < NT) DMA3(bn, j + 2);
        QKT3(pA0, pA1, bc);
        finishSM(pB0, pB1, alB, l_reg, pa0, pa1, pa2, pa3);
        pv_d0(o, VB3(bp), pa0, pa1, pa2, pa3); partialSM<MLA>(pA0, pA1, m_reg, mnA, alA);
        asm volatile("s_waitcnt vmcnt(0)" ::: "memory"); __syncthreads();
        RESC3(alA);
        { const int t_ = bp; bp = bc; bc = bn; bn = t_; }
    }
    SBAR(); QKT3(pB0, pB1, bc);
    finishSM(pA0, pA1, alA, l_reg, pa0, pa1, pa2, pa3); SBAR();
    pv_d0(o, VB3(bp), pa0, pa1, pa2, pa3); partialSM<MLA>(pB0, pB1, m_reg, mnB, alB);
    RESC3(alB);
    finishSM(pB0, pB1, alB, l_reg, pa0, pa1, pa2, pa3); SBAR();
    pv_d0(o, VB3(bc), pa0, pa1, pa2, pa3);
    if (hi == 0) li_l[r32] = l_reg; asm volatile("s_waitcnt lgkmcnt(0)" ::: "memory");
    float rli[16];
#pragma unroll
    for (int r = 0; r < 16; ++r) rli[r] = __builtin_amdgcn_rcpf(li_l[crow(r, hi)]);
    if (do_store) {
#pragma unroll
    for (int r = 0; r < 16; ++r) { const int orow = crow(r, hi);
#pragma unroll
        for (int d0 = 0; d0 < 4; ++d0) gst<bf16_t>(Ow + (size_t)orow * ldo + d0 * 32 + r32, f2bf(o[d0][r] * rli[r])); }
    }
    __syncthreads();
#undef QKT3
#undef DMA3
#undef RESC3
#undef VB3
}

enum { MAP_PLAIN = 0, MAP_FFN_IN, MAP_SGU_IN, MAP_MLA_IN };
__device__ __forceinline__ int map_col(int mode, int n0) {
    if (mode == MAP_FFN_IN) { const int pn = n0 >> 8, w = n0 & 255; return (w >> 7) * DFF + pn * 128 + (w & 127); }
    if (mode == MAP_SGU_IN) { return n0 < 1536 ? n0 : (n0 < 2048 ? 3072 + (n0 - 1536) : 1536 + (n0 - 2048)); }
    if (mode == MAP_MLA_IN) { return n0 < 448 ? n0 : (n0 < 512 ? -1 : 448 + (n0 - 512)); }
    return n0;
}
__device__ __forceinline__ int cvtT(const float* __restrict__ src, int sld, int K, int N, bf16_t* __restrict__ dst, const float* __restrict__ gain, float scale, int mode, float* tile, const int tid, int& tnext, int tbase) {
    const int ntk = K / 64, ntn = N / 256, tx = tid & 63, ty = tid >> 6;
    for (; tnext < tbase + ntk * ntn; tnext += NCU) {
        const int t = tnext - tbase, nb = t / ntk, kb = t % ntk; const int sc = map_col(mode, nb * 256 + (tx >> 4) * 64);
        __syncthreads();
        f32x4 v[8];
#pragma unroll
        for (int ps = 0; ps < 8; ++ps) { v[ps] = (f32x4){0.f, 0.f, 0.f, 0.f}; if (sc >= 0) v[ps] = gld<f32x4>(src + (size_t)(kb * 64 + ps * 8 + ty) * sld + sc + (tx & 15) * 4); }
#pragma unroll
        for (int ps = 0; ps < 8; ++ps) { const int kk = ps * 8 + ty; const float g = gain ? gld<float>(gain + kb * 64 + kk) * scale : scale; *(f32x4*)(tile + kk * 260 + tx * 4) = v[ps] * g; }
        __syncthreads();
#pragma unroll
        for (int q = 0; q < 4; ++q) {
            const int item = q * 512 + tid, n = item & 255, k8 = (item >> 8) * 8;
            u32x4 w;
            w[0] = cvtpk(tile[(k8 + 0) * 260 + n], tile[(k8 + 1) * 260 + n]); w[1] = cvtpk(tile[(k8 + 2) * 260 + n], tile[(k8 + 3) * 260 + n]);
            w[2] = cvtpk(tile[(k8 + 4) * 260 + n], tile[(k8 + 5) * 260 + n]); w[3] = cvtpk(tile[(k8 + 6) * 260 + n], tile[(k8 + 7) * 260 + n]);
            gst<u32x4>(dst + (size_t)(nb * 256 + n) * K + kb * 64 + k8, w);
        }
    }
    return tbase + ntk * ntn;
}

enum { OP_PREP = 0, OP_GSYNC, OP_G_MEMKV, OP_G_FFN1, OP_G_FFN2, OP_G_SGU_IN, OP_MIX, OP_MEMATT, OP_G_SGU_OUT, OP_G_MLA_IN, OP_KVPOST, OP_G_MLA_Q, OP_MLA_ATT, OP_G_MLA_OUT, OP_FINAL };
#define PC(op, l, sub) (unsigned char)((op) | ((l) << 4) | ((sub) << 6))
#define SGU_LAYER(l) PC(OP_G_FFN1, l, 0), PC(OP_G_FFN2, l, 0), PC(OP_G_SGU_IN, l, 0), PC(OP_MIX, l, 0), PC(OP_MEMATT, l, 0), PC(OP_G_SGU_OUT, l, 0), PC(OP_G_FFN1, l, 1), PC(OP_G_FFN2, l, 1)
#define MLA_LAYER(l) PC(OP_G_FFN1, l, 0), PC(OP_G_FFN2, l, 0), PC(OP_G_MLA_IN, l, 0), PC(OP_KVPOST, l, 0), PC(OP_G_MLA_Q, l, 0), PC(OP_GSYNC, l, 0), PC(OP_MLA_ATT, l, 0), PC(OP_MEMATT, l, 0), PC(OP_G_MLA_OUT, l, 0), PC(OP_G_FFN1, l, 1), PC(OP_G_FFN2, l, 1)
constexpr int NPROG = 46;
__constant__ unsigned char PROG[NPROG] = {
    PC(OP_PREP, 0, 0), PC(OP_GSYNC, 0, 0), PC(OP_G_MEMKV, 0, 0), PC(OP_GSYNC, 0, 0),
    SGU_LAYER(0), MLA_LAYER(1),
    PC(OP_GSYNC, 0, 0), PC(OP_PREP, 2, 0), PC(OP_GSYNC, 0, 0),
    SGU_LAYER(2), MLA_LAYER(3),
    PC(OP_FINAL, 0, 0) };

__global__ __launch_bounds__(512, 2) void fwd_megakernel(Params p) {
    extern __shared__ __attribute__((aligned(16))) unsigned char shm[];
    cg::grid_group grid = cg::this_grid();
    const int cu = blockIdx.x;
    LAS unsigned char* lds = (LAS unsigned char*)shm;
    float* st = (float*)(shm + LDS_ST);
    float* st_rsx = st, *st_rv = st + 256, *st_rq = st + 512, *st_xacc = st + 1024, *st_vacc = st + 2048, *st_qacc = st + 3072;
    float* tile = (float*)shm;
    const float** tab = (const float**)(shm + LDS_TAB);
    if (threadIdx.x < 26) tab[threadIdx.x] = p.in[threadIdx.x];
    __syncthreads();
#define PIN(i) as_global(((const float* volatile*)tab)[i])
    grid.sync();
    int nsync = 0;
    for (int pc = 0; pc < NPROG; ++pc) {
        int tid = threadIdx.x; asm volatile("" : "+v"(tid));
        const int wid = tid >> 6, lane = tid & 63;
        unsigned char* ws = p.ws; float* outp = p.out; asm volatile("" : "+s"(ws), "+s"(outp)); ws = as_global(ws); outp = as_global(outp);
        bf16_t* X = (bf16_t*)outp;
        unsigned char* slab = ws + WS_SCR + (size_t)cu * SLAB;
        bf16_t* HID = (bf16_t*)(slab + SCR_HID);
        bf16_t* Pb = (bf16_t*)(slab + SCR_P);
        bf16_t* VT = (bf16_t*)(slab + SCR_VT);
        bf16_t* QF = (bf16_t*)(slab + SCR_QF);
        bf16_t* C2 = (bf16_t*)(slab + SCR_C2);
        bf16_t* KB = (bf16_t*)(ws + WS_KBUF);
        bf16_t* MEMKV = (bf16_t*)(ws + WS_MEMKV);
        float* kvraw = (float*)(C2 + 256);
        const float* rcos = (const float*)(ws + WS_ROPE); const float* rsin = rcos + 16384 * 32;
        const size_t hstepTok = (size_t)TPROMPT * 2;
        const size_t hstepLoc = (size_t)128 * 2;

#ifdef RUN_UNTIL
        if (pc >= RUN_UNTIL && pc != NPROG - 1) continue;
#endif
        const int code = PROG[pc], op = code & 15, l = (code >> 4) & 3, sub = (code >> 6) & 1, dup = code >> 7, j = l >> 1;
        unsigned char* slot = ws + ((l & 1) ? WS_SLOTB : WS_SLOTA);
        const bool is_gemm = (op == OP_G_MEMKV || op == OP_G_FFN1 || op == OP_G_FFN2 || op == OP_G_SGU_IN || op == OP_G_SGU_OUT || op == OP_G_MLA_IN || op == OP_G_MLA_Q || op == OP_G_MLA_OUT);
        if (is_gemm) {
            GemmArgs g{}; Epi e{}; e.cu = cu; e.ws = ws; e.out = outp; e.st = st; e.alpha = 1.f; bool run = true;
            if (op == OP_G_MEMKV) {
                run = cu < 96; const int ll = cu / 24, rem = cu % 24, rb = rem >> 2, pn = rem & 3;
                g.A = (const bf16_t*)(ws + WS_MEMN) + (size_t)rb * 256 * 1024; g.hstepA = (size_t)128 * 1024 * 2; g.lda = 1024;
                g.Bt = (const bf16_t*)(ws + WS_MEMW) + ((size_t)ll * 1024 + pn * 256) * 1024; g.K = 1024; g.nN = 1;
                e.mode = EP_MEMKV;
            } else if (op == OP_G_FFN1) {
                g.A = X + (size_t)cu * 128 * XLD; g.hstepA = hstepTok * XLD; g.lda = XLD; g.Bt = (const bf16_t*)(slot + (sub == 0 ? SL_F1I : SL_F2I)); g.K = 1024; g.nN = 22;
                e.mode = EP_FFN1;
            } else if (op == OP_G_FFN2) {
                g.A = HID; g.hstepA = hstepLoc * HID_LD; g.lda = HID_LD; g.Bt = (const bf16_t*)(slot + (sub == 0 ? SL_F1O : SL_F2O)); g.K = 2816; g.nN = 4;
                e.mode = EP_XUPD; e.alpha = dup ? 0.f : 0.5f;
            } else if (op == OP_G_SGU_IN) {
                g.A = X + (size_t)cu * 128 * XLD; g.hstepA = hstepTok * XLD; g.lda = XLD; g.Bt = (const bf16_t*)(slot + SG_IN); g.K = 1024; g.nN = 14;
                e.mode = EP_SGU_IN;
                if (tid < 256) { st_vacc[tid] = 0.f; st_vacc[256 + tid] = 0.f; st_vacc[512 + tid] = 0.f; st_vacc[768 + tid] = 0.f; }
            } else if (op == OP_G_SGU_OUT) {
                g.A = Pb; g.hstepA = hstepLoc * P_LD; g.lda = P_LD; g.Bt = (const bf16_t*)(slot + SG_OUT); g.K = 2048; g.nN = 4;
                e.mode = EP_XUPD; e.alpha = 1.0f;
            } else if (op == OP_G_MLA_IN) {
                g.A = X + (size_t)cu * 128 * XLD; g.hstepA = hstepTok * XLD; g.lda = XLD; g.Bt = (const bf16_t*)(slot + ML_IN); g.K = 1024; g.nN = 4;
                e.mode = EP_MLA_IN;
                if (tid < 256) { st_qacc[tid] = 0.f; st_qacc[256 + tid] = 0.f; st_qacc[512 + tid] = 0.f; st_qacc[768 + tid] = 0.f; }
            } else if (op == OP_G_MLA_Q) {
                g.A = C2; g.hstepA = hstepLoc * C2_LD; g.lda = C2_LD; g.Bt = (const bf16_t*)(slot + ML_Q); g.K = 256; g.nN = 6;
                e.mode = EP_MLA_Q;
            } else {
                g.A = C2; g.hstepA = hstepLoc * C2_LD; g.lda = C2_LD; g.Bt = (const bf16_t*)(slot + ML_OUT); g.K = 1536; g.nN = 4;
                e.mode = EP_XUPD; e.alpha = 1.0f;
            }
            __syncthreads();
            if (run) gemm_phase(lds, g, e, tid);
            if (tid < 256) {
                if (e.mode == EP_XUPD) { st_rsx[tid] = rsqrtf(((st_xacc[tid] + st_xacc[256 + tid]) + (st_xacc[512 + tid] + st_xacc[768 + tid])) * (1.f / 1024.f) + EPS); st_xacc[tid] = 0.f; st_xacc[256 + tid] = 0.f; st_xacc[512 + tid] = 0.f; st_xacc[768 + tid] = 0.f; }
                else if (e.mode == EP_SGU_IN) st_rv[tid] = rsqrtf(((st_vacc[tid] + st_vacc[256 + tid]) + (st_vacc[512 + tid] + st_vacc[768 + tid])) * (1.f / 1536.f) + EPS);
                else if (e.mode == EP_MLA_IN) st_rq[tid] = rsqrtf(((st_qacc[tid] + st_qacc[256 + tid]) + (st_qacc[512 + tid] + st_qacc[768 + tid])) * (1.f / 256.f) + EPS);
            }
            __syncthreads();
        } else if (op == OP_GSYNC) {
            __builtin_amdgcn_fence(__ATOMIC_RELEASE, "agent"); asm volatile("s_waitcnt vmcnt(0) lgkmcnt(0)" ::: "memory");
            __syncthreads();
            ++nsync;
            if (tid == 0) {
                unsigned* bar = (unsigned*)(ws + WS_BAR);
                __hip_atomic_fetch_add(bar, 1u, __ATOMIC_RELAXED, __HIP_MEMORY_SCOPE_AGENT);
                while (__hip_atomic_load(bar, __ATOMIC_RELAXED, __HIP_MEMORY_SCOPE_AGENT) < (unsigned)(NCU * nsync)) __builtin_amdgcn_s_sleep(4);
            }
            __syncthreads();
            __builtin_amdgcn_fence(__ATOMIC_ACQUIRE, "agent"); asm volatile("s_waitcnt vmcnt(0) lgkmcnt(0)" ::: "memory");
            __syncthreads();
        } else if (op == OP_PREP) {
            const int nitems = (l == 0) ? 16 : 12; int tnext = cu, tbase = 0;
            for (int item = 0; item < nitems; ++item) {
                const float* src; int sld, K, N, mode = MAP_PLAIN; bf16_t* dst; const float* gain = nullptr; bool skip = false;
                if (item < 12) {
                    const int ll = l + item / 6, m = item % 6; unsigned char* sl = ws + ((ll & 1) ? WS_SLOTB : WS_SLOTA); const int jj = ll >> 1;
                    if (m == 0 || m == 2) { src = PIN(m == 0 ? 5 : 11) + (size_t)ll * 1024 * 5632; sld = 5632; K = 1024; N = 5632; dst = (bf16_t*)(sl + (m == 0 ? SL_F1I : SL_F2I)); gain = PIN(m == 0 ? 4 : 10) + ll * 1024; mode = MAP_FFN_IN; }
                    else if (m == 1 || m == 3) { src = PIN(m == 1 ? 6 : 12) + (size_t)ll * 2816 * 1024; sld = 1024; K = 2816; N = 1024; dst = (bf16_t*)(sl + (m == 1 ? SL_F1O : SL_F2O)); }
                    else if (m == 4) {
                        if ((ll & 1) == 0) { src = PIN(13) + (size_t)jj * 1024 * 3584; sld = 3584; K = 1024; N = 3584; dst = (bf16_t*)(sl + SG_IN); gain = PIN(7) + ll * 1024; mode = MAP_SGU_IN; }
                        else { src = PIN(18) + (size_t)jj * 1024 * 960; sld = 960; K = 1024; N = 1024; dst = (bf16_t*)(sl + ML_IN); gain = PIN(7) + ll * 1024; mode = MAP_MLA_IN; }
                    } else {
                        if ((ll & 1) == 0) { src = PIN(17) + (size_t)jj * 2048 * 1024; sld = 1024; K = 2048; N = 1024; dst = (bf16_t*)(sl + SG_OUT); }
                        else { skip = true; src = nullptr; sld = K = N = 64; dst = nullptr; }
                    }
                } else { const int ll = item - 12; src = PIN(9) + (size_t)ll * 1024 * 1024; sld = 1024; K = 1024; N = 1024; dst = (bf16_t*)(ws + WS_MEMW) + (size_t)ll * 1024 * 1024; gain = PIN(8) + ll * 1024; }
                if (!skip) tbase = cvtT(src, sld, K, N, dst, gain, 1.f, mode, tile, tid, tnext, tbase);
            }
            __syncthreads();
            const size_t gt = (size_t)cu * NTHR + tid, gn = (size_t)NCU * NTHR;
            {
                const int jj = l >> 1; const float* wsp = PIN(15) + (size_t)jj * 8 * 128 * 128; bf16_t* d = (bf16_t*)(ws + WS_SLOTA + SG_WS);
                for (size_t i = gt; i < (size_t)8 * 128 * 128; i += gn) d[i] = f2bf(wsp[i]);
            }
            {
                const int jj = l >> 1; unsigned char* sl = ws + WS_SLOTB;
                const float* wuq = PIN(20) + (size_t)jj * 256 * 1536; const float* wuk = PIN(22) + (size_t)jj * 128 * 8 * 128; const float* qn = PIN(19) + jj * 256;
                bf16_t* dq = (bf16_t*)(sl + ML_Q); const float qs = 0.07216878364870322f;
                for (size_t i = gt; i < (size_t)1536 * 256; i += gn) {
                    const int n = (int)(i >> 8), k = (int)(i & 255); float v;
                    if (n < 1024) { const int h = n >> 7, c = n & 127; const float* a = wuq + (size_t)k * 1536 + h * 192; const float* b = wuk + ((size_t)c * 8 + h) * 128; float sacc = 0.f;
                        for (int d = 0; d < 128; d += 4) { const f32x4 x = *(const f32x4*)(a + d), y = *(const f32x4*)(b + d); sacc += x[0] * y[0] + x[1] * y[1] + x[2] * y[2] + x[3] * y[3]; } v = sacc; }
                    else { const int rem = n - 1024, t = rem >> 8, w = rem & 255, half = w >> 7, hh = (w & 127) >> 5, j2 = w & 31; v = wuq[(size_t)k * 1536 + (4 * t + hh) * 192 + 128 + 32 * half + j2]; }
                    dq[i] = f2bf(v * qn[k] * qs);
                }
                const float* wuv = PIN(23) + (size_t)jj * 128 * 8 * 128; const float* wo = PIN(24) + (size_t)jj * 1536 * 1024; bf16_t* dout = (bf16_t*)(sl + ML_OUT);
                for (size_t i = gt; i < (size_t)8 * 64 * 256; i += gn) {
                    const int n = (int)(i & 255) * 4, c = (int)((i >> 8) & 63) * 2, h = (int)(i >> 14);
                    const float* a0 = wuv + ((size_t)c * 8 + h) * 128; const float* a1 = a0 + 8 * 128; const float* b = wo + (size_t)(h * 128) * 1024 + n;
                    f32x4 s0 = {0.f, 0.f, 0.f, 0.f}, s1 = {0.f, 0.f, 0.f, 0.f};
#pragma unroll 8
                    for (int d = 0; d < 128; ++d) { const f32x4 bv = *(const f32x4*)(b + (size_t)d * 1024); s0 += bv * a0[d]; s1 += bv * a1[d]; }
                    const int kk = h * 128 + c;
#pragma unroll
                    for (int q = 0; q < 4; ++q) *(unsigned*)(dout + (size_t)(n + q) * 1536 + kk) = cvtpk(s0[q], s1[q]);
                }
                for (size_t i = gt; i < (size_t)512 * 256; i += gn) {
                    const int kk = 1024 + (int)(i >> 8), n = (int)(i & 255) * 4; const f32x4 v = *(const f32x4*)(wo + (size_t)kk * 1024 + n);
#pragma unroll
                    for (int q = 0; q < 4; ++q) dout[(size_t)(n + q) * 1536 + kk] = f2bf(v[q]);
                }
            }
            if (l == 0) {
                {
                    bf16_t* memn = (bf16_t*)(ws + WS_MEMN);
                    for (int r = cu * 8 + wid; r < 1536; r += NCU * 8) {
                        const float* src = r < 1024 ? PIN(2) + (size_t)r * 1024 : PIN(3) + (size_t)(r - 1024) * 1024;
                        f32x4 v[4]; float ss = 0.f;
#pragma unroll
                        for (int q = 0; q < 4; ++q) { v[q] = *(const f32x4*)(src + q * 256 + lane * 4); ss += v[q][0] * v[q][0] + v[q][1] * v[q][1] + v[q][2] * v[q][2] + v[q][3] * v[q][3]; }
                        ss = wave_sum(ss); const float rs = rsqrtf(ss * (1.f / 1024.f) + EPS);
#pragma unroll
                        for (int q = 0; q < 4; ++q) { u32x2 w; w[0] = cvtpk(v[q][0] * rs, v[q][1] * rs); w[1] = cvtpk(v[q][2] * rs, v[q][3] * rs); *(u32x2*)(memn + (size_t)r * 1024 + q * 256 + lane * 4) = w; }
                    }
                }
                {
                    float* c = (float*)(ws + WS_ROPE); float* s = c + 16384 * 32;
                    for (int i = cu * NTHR + tid; i < 16384 * 32; i += NCU * NTHR) {
                        const int pos = i >> 5, jj = i & 31;
                        double bp = 1.0; for (int t = 0; t < jj; ++t) bp *= 1.333521432163324;
                        const float invf = 1.0f / (float)bp;
                        const float ang = (float)pos * invf;
                        const double ad = (double)ang, kq = rint(ad * 0.6366197723675814);
                        const double r = (ad - kq * 1.5707963267948966) - kq * 6.123233995736766e-17, r2 = r * r;
                        const double sr = r * (1.0 + r2 * (-1.0 / 6 + r2 * (1.0 / 120 + r2 * (-1.0 / 5040 + r2 * (1.0 / 362880 + r2 * (-1.0 / 39916800 + r2 * (1.0 / 6227020800.0)))))));
                        const double cr = 1.0 + r2 * (-0.5 + r2 * (1.0 / 24 + r2 * (-1.0 / 720 + r2 * (1.0 / 40320 + r2 * (-1.0 / 3628800 + r2 * (1.0 / 479001600.0 + r2 * (-1.0 / 87178291200.0)))))));
                        const int qd = ((int)kq) & 3;
                        const double sd = (qd == 0) ? sr : (qd == 1) ? cr : (qd == 2) ? -sr : -cr;
                        const double cd = (qd == 0) ? cr : (qd == 1) ? -sr : (qd == 2) ? -cr : sr;
                        c[i] = (float)cd; s[i] = (float)sd;
                    }
                }
                {
                    const float* xin0 = PIN(0); const float* xin1 = PIN(1);
                    for (int it = 0; it < 8; ++it) {
                        f32x4 v[4][4];
#pragma unroll
                        for (int u = 0; u < 4; ++u) { const int rr = wid + 8 * (4 * it + u), ai = rr >> 7, pr = rr & 127; const float* src = (ai ? xin1 : xin0) + ((size_t)cu * 128 + pr) * 1024;
#pragma unroll
                            for (int q = 0; q < 4; ++q) v[u][q] = gld<f32x4>(src + q * 256 + lane * 4); }
#pragma unroll
                        for (int u = 0; u < 4; ++u) { const int rr = wid + 8 * (4 * it + u), ai = rr >> 7, pr = rr & 127;
                            bf16_t* dst = X + ((size_t)ai * TPROMPT + (size_t)cu * 128 + pr) * XLD; float ss = 0.f;
#pragma unroll
                            for (int q = 0; q < 4; ++q) ss += v[u][q][0] * v[u][q][0] + v[u][q][1] * v[u][q][1] + v[u][q][2] * v[u][q][2] + v[u][q][3] * v[u][q][3];
                            ss = wave_sum(ss);
#pragma unroll
                            for (int q = 0; q < 4; ++q) {
                                u32x2 h, lo; h[0] = cvtpk(v[u][q][0], v[u][q][1]); h[1] = cvtpk(v[u][q][2], v[u][q][3]);
                                gst<u32x2>(dst + q * 256 + lane * 4, h);
                                if (XLO) { lo[0] = cvtpk(v[u][q][0] - bflo(h[0]), v[u][q][1] - bfhi(h[0])); lo[1] = cvtpk(v[u][q][2] - bflo(h[1]), v[u][q][3] - bfhi(h[1])); gst<u32x2>(dst + 1024 + q * 256 + lane * 4, lo); }
                            }
                            if (lane == 0) st_rsx[rr] = rsqrtf(ss * (1.f / 1024.f) + EPS);
                        }
                    }
                    if (tid < 256) { st_xacc[tid] = 0.f; st_xacc[256 + tid] = 0.f; st_xacc[512 + tid] = 0.f; st_xacc[768 + tid] = 0.f; }
                }
            }
        } else if (op == OP_MIX) {
#ifndef NO_MIX
            const int gi = wid, fr = lane & 15, fq = lane >> 4;
            const bf16_t* Wsg = (const bf16_t*)(slot + SG_WS) + (size_t)gi * 128 * 128;
            const float* vgain = PIN(14) + j * 1536 + gi * 192; const float* bs = PIN(16) + (size_t)j * 8 * 128 + gi * 128;
            for (int ai = 0; ai < 2; ++ai) {
                float rvq[4][8];
#pragma unroll
                for (int ks = 0; ks < 4; ++ks)
#pragma unroll
                    for (int i = 0; i < 8; ++i) rvq[ks][i] = st_rv[ai * 128 + ks * 32 + fq * 8 + i];
                const bf16_t* vtg = VT + ((size_t)ai * 1536 + gi * 192) * 128;
                for (int ph = 0; ph < 2; ++ph) {
                    bf16x8 bw[4][4];
#pragma unroll
                    for (int pb = 0; pb < 4; ++pb)
#pragma unroll
                        for (int ks = 0; ks < 4; ++ks) bw[pb][ks] = gld<bf16x8>(Wsg + (size_t)(ph * 64 + pb * 16 + fr) * 128 + ks * 32 + fq * 8);
                    for (int cb = 0; cb < 12; ++cb) {
                        bf16x8 af[4];
#pragma unroll
                        for (int ks = 0; ks < 4; ++ks) {
                            const u32x4 raw = gld<u32x4>(vtg + (size_t)(cb * 16 + fr) * 128 + ks * 32 + fq * 8);
                            u32x4 w;
#pragma unroll
                            for (int i = 0; i < 4; ++i) w[i] = cvtpk(bflo(raw[i]) * rvq[ks][2 * i], bfhi(raw[i]) * rvq[ks][2 * i + 1]);
                            af[ks] = *reinterpret_cast<bf16x8*>(&w);
                        }
                        f32x4 d[4];
#pragma unroll
                        for (int pb = 0; pb < 4; ++pb) { d[pb] = (f32x4){0.f, 0.f, 0.f, 0.f};
#pragma unroll
                            for (int ks = 0; ks < 4; ++ks) d[pb] = __builtin_amdgcn_mfma_f32_16x16x32_bf16(af[ks], bw[pb][ks], d[pb], 0, 0, 0); }
                        const f32x4 gn = gld<f32x4>(vgain + cb * 16 + fq * 4);
#pragma unroll
                        for (int pb = 0; pb < 4; ++pb) {
                            const int pr = ph * 64 + pb * 16 + fr; const float bb = gld<float>(bs + pr);
                            bf16_t* up = Pb + (size_t)(ai * 128 + pr) * P_LD + gi * 192 + cb * 16 + fq * 4;
                            const u32x2 uw = gld<u32x2>(up);
                            u32x2 w; w[0] = cvtpk(bflo(uw[0]) * (gn[0] * d[pb][0] + bb), bfhi(uw[0]) * (gn[1] * d[pb][1] + bb));
                            w[1] = cvtpk(bflo(uw[1]) * (gn[2] * d[pb][2] + bb), bfhi(uw[1]) * (gn[3] * d[pb][3] + bb));
                            gst<u32x2>(up, w);
                        }
                    }
                }
            }
            __syncthreads();
#endif
        } else if (op == OP_MEMATT) {
#ifndef NO_MEMATT
            static_assert(P_LD == C2_LD, "one row stride for both concat buffers"); bf16_t* buf = (l & 1) ? C2 : Pb; constexpr int ld = P_LD; const int qoff = (l & 1) ? 1024 : 1536;
            for (int it = 0; it < 8; ++it) {
                int t2 = tid; asm volatile("" : "+v"(t2)); const int wid = t2 >> 6;
                const int ai = it >> 2, h = it & 3; const int mb = ai ? 4 + (cu >> 7) : (cu >> 6);
                const bf16_t* kg = MEMKV + ((size_t)l * 1536 + mb * 256) * 1024 + h * 128;
                bf16_t* q = buf + (size_t)(ai * 128 + (wid & 3) * 32) * ld + qoff + h * 128;
                #if MLA_DMA
                attn_dma<false, P_LD, 1024, P_LD>(q, kg, kg + 512, 256, q, wid < 4, (char*)shm, t2);
#else
                attn_body<false, P_LD, 1024, P_LD>(q, kg, kg + 512, 256, q, wid < 4, (char*)shm, t2);
#endif
            }
#endif
        } else if (op == OP_KVPOST) {
            const float* kvg = PIN(21) + j * 128;
            const float g0 = gld<float>(kvg + lane * 2), g1 = gld<float>(kvg + lane * 2 + 1);
            for (int it = 0; it < 8; ++it) {
                float a0[4], a1[4], x1[4], x2[4], cc[4], sn[4];
#pragma unroll
                for (int u = 0; u < 4; ++u) { const int rr = wid + 8 * (4 * it + u), ai = rr >> 7, pr = rr & 127; const float* src = kvraw + (size_t)rr * (C2_LD / 2);
                    const int pos = (cu * 128 + pr) & (ai ? 16383 : 8191), l32 = lane & 31;
                    a0[u] = gld<float>(src + lane * 2); a1[u] = gld<float>(src + lane * 2 + 1);
                    x1[u] = gld<float>(src + 128 + l32); x2[u] = gld<float>(src + 160 + l32); cc[u] = gld<float>(rcos + pos * 32 + l32); sn[u] = gld<float>(rsin + pos * 32 + l32); }
#pragma unroll
                for (int u = 0; u < 4; ++u) { const int rr = wid + 8 * (4 * it + u), ai = rr >> 7, pr = rr & 127; const size_t g = (size_t)ai * TPROMPT + (size_t)cu * 128 + pr;
                    const float ss = wave_sum(a0[u] * a0[u] + a1[u] * a1[u]); const float rs = rsqrtf(ss * (1.f / 128.f) + EPS);
                    bf16_t* kd = KB + g * K_LD;
                    gst<unsigned>(kd + lane * 2, cvtpk(a0[u] * rs * g0, a1[u] * rs * g1));
                    if (lane < 32) { gst<bf16_t>(kd + 128 + lane, f2bf(x1[u] * cc[u] - x2[u] * sn[u])); gst<bf16_t>(kd + 160 + lane, f2bf(x1[u] * sn[u] + x2[u] * cc[u])); }
                }
            }
            __syncthreads();
        } else if (op == OP_MLA_ATT) {
#ifndef NO_MLAATT
            for (int it = 0; it < 8; ++it) {
                int t2 = tid; asm volatile("" : "+v"(t2)); const int wid = t2 >> 6;
                const int ai = it >> 2, hp = it & 3; const int seq = ai ? 16384 : 8192;
                const size_t g0 = (size_t)ai * TPROMPT + (size_t)cu * 128;
                const size_t s0 = (size_t)ai * TPROMPT + ((size_t)cu * 128 / seq) * seq;
                const int head = 2 * hp + (wid >> 2);
                const size_t lrow0 = (size_t)(ai * 128 + (wid & 3) * 32);
                #if MLA_DMA
                attn_dma<true, QF_LD, K_LD, C2_LD>(QF + lrow0 * QF_LD + head * 192, KB + s0 * K_LD, nullptr, seq, C2 + lrow0 * C2_LD + head * 128, true, (char*)shm, t2);
#else
                attn_body<true, QF_LD, K_LD, C2_LD>(QF + lrow0 * QF_LD + head * 192, KB + s0 * K_LD, nullptr, seq, C2 + lrow0 * C2_LD + head * 128, true, (char*)shm, t2);
#endif
            }
#endif
        } else {
            const float* fg = PIN(25);
            f32x4 gq[4];
#pragma unroll
            for (int q = 0; q < 4; ++q) gq[q] = gld<f32x4>(fg + q * 256 + lane * 4);
            for (int it = 0; it < 8; ++it) {
                u32x2 h[4][4], lo[4][4];
#pragma unroll
                for (int u = 0; u < 4; ++u) { const int rr = wid + 8 * (4 * it + u), ai = rr >> 7, pr = rr & 127; const bf16_t* row = X + ((size_t)ai * TPROMPT + (size_t)cu * 128 + pr) * XLD;
#pragma unroll
                    for (int q = 0; q < 4; ++q) { h[u][q] = gld<u32x2>(row + q * 256 + lane * 4); lo[u][q] = (u32x2){0u, 0u}; if (XLO) lo[u][q] = gld<u32x2>(row + 1024 + q * 256 + lane * 4); } }
                asm volatile("s_waitcnt vmcnt(0)" ::: "memory");
#pragma unroll
                for (int u = 0; u < 4; ++u) { const int rr = wid + 8 * (4 * it + u), ai = rr >> 7, pr = rr & 127; float* orow = (float*)(X + ((size_t)ai * TPROMPT + (size_t)cu * 128 + pr) * XLD); const float rs = st_rsx[rr];
#pragma unroll
                    for (int q = 0; q < 4; ++q) {
                        f32x4 y; y[0] = (bflo(h[u][q][0]) + bflo(lo[u][q][0])) * rs * gq[q][0]; y[1] = (bfhi(h[u][q][0]) + bfhi(lo[u][q][0])) * rs * gq[q][1];
                        y[2] = (bflo(h[u][q][1]) + bflo(lo[u][q][1])) * rs * gq[q][2]; y[3] = (bfhi(h[u][q][1]) + bfhi(lo[u][q][1])) * rs * gq[q][3];
                        gst<f32x4>(orow + q * 256 + lane * 4, y);
                    }
                }
            }
        }
    }
}

extern "C" void kernel_launch(void* const* d_in, const int* in_sizes, int n_in, void* d_out, int out_size, void* d_ws, size_t ws_size, hipStream_t stream) {
    static int ready = 0;
    if (ready == 0) {
        if (n_in != 26 || out_size != NTOK * DM || ws_size < WS_END) { fprintf(stderr, "kernel_launch: unexpected shapes (n_in %d out %d ws %zu need %zu)\n", n_in, out_size, ws_size, (size_t)WS_END); ready = -1; return; }
        if (hipFuncSetAttribute((const void*)fwd_megakernel, hipFuncAttributeMaxDynamicSharedMemorySize, LDS_TOTAL) != hipSuccess) { fprintf(stderr, "kernel_launch: hipFuncSetAttribute failed\n"); ready = -1; return; }
        int per_cu = 0; (void)hipOccupancyMaxActiveBlocksPerMultiprocessor(&per_cu, (const void*)fwd_megakernel, NTHR, LDS_TOTAL); (void)hipGetLastError();
        ready = 1;
    }
    if (ready < 0) return;
    Params p{};
    for (int i = 0; i < 26; ++i) p.in[i] = (const float*)d_in[i];
    p.out = (float*)d_out; p.ws = (unsigned char*)d_ws;
    if (hipMemsetAsync((unsigned char*)d_ws + WS_BAR, 0, 256, stream) != hipSuccess) { fprintf(stderr, "kernel_launch: memset of the barrier word failed\n"); return; }
    void* args[] = {&p};
    hipError_t e = hipLaunchCooperativeKernel((const void*)fwd_megakernel, dim3(NCU), dim3(NTHR), args, LDS_TOTAL, stream);
    if (e != hipSuccess) fprintf(stderr, "kernel_launch: cooperative launch failed: %s\n", hipGetErrorString(e));
}
```

```cpp
#include <hip/hip_runtime.h>
#include <hip/hip_cooperative_groups.h>
#include <cstdio>
#include <cstdint>
namespace cg = cooperative_groups;

#define LAS __attribute__((address_space(3)))
typedef unsigned short bf16_t;
typedef short bf16x8 __attribute__((ext_vector_type(8)));
typedef short s16x4 __attribute__((ext_vector_type(4)));
typedef float f32x4 __attribute__((ext_vector_type(4)));
typedef float f32x16 __attribute__((ext_vector_type(16)));
typedef unsigned u32x2 __attribute__((ext_vector_type(2)));
typedef unsigned u32x4 __attribute__((ext_vector_type(4)));

constexpr int NTOK = 65536, TPROMPT = 32768, DM = 1024, DFF = 2816;
constexpr int NCU = 256, NTHR = 512;
constexpr float EPS = 1e-6f;
#ifndef XLO
#define XLO 0
#endif
constexpr int XLD = 2048;
constexpr int HID_LD = 2816, P_LD = 2048, C2_LD = 2048, QF_LD = 1536, K_LD = 192;
constexpr int LDS_STAGE = 131072, LDS_TOTAL = 163840, LDS_ST = 131072, LDS_TAB = 159488;

constexpr size_t SZ_FFN_IN = (size_t)5632 * 1024 * 2, SZ_FFN_OUT = (size_t)1024 * 2816 * 2;
constexpr size_t SL_F1I = 0, SL_F1O = SL_F1I + SZ_FFN_IN, SL_F2I = SL_F1O + SZ_FFN_OUT, SL_F2O = SL_F2I + SZ_FFN_IN, SL_MIX = SL_F2O + SZ_FFN_OUT;
constexpr size_t SG_IN = SL_MIX, SG_OUT = SG_IN + (size_t)3584 * 1024 * 2, SG_WS = SG_OUT + (size_t)1024 * 2048 * 2, SLOTA_SZ = SG_WS + (size_t)8 * 128 * 128 * 2;
constexpr size_t ML_IN = SL_MIX, ML_Q = ML_IN + (size_t)1024 * 1024 * 2, ML_OUT = ML_Q + (size_t)1536 * 256 * 2, SLOTB_SZ = ML_OUT + (size_t)1024 * 1536 * 2;
constexpr size_t WS_SLOTA = 0, WS_SLOTB = WS_SLOTA + SLOTA_SZ;
constexpr size_t WS_MEMW = WS_SLOTB + SLOTB_SZ;
constexpr size_t WS_MEMN = WS_MEMW + (size_t)4 * 1024 * 1024 * 2;
constexpr size_t WS_MEMKV = WS_MEMN + (size_t)1536 * 1024 * 2;
constexpr size_t WS_ROPE = WS_MEMKV + (size_t)4 * 1536 * 1024 * 2;
constexpr size_t WS_KBUF = WS_ROPE + (size_t)2 * 16384 * 32 * 4;
constexpr size_t WS_SCR = WS_KBUF + (size_t)NTOK * K_LD * 2;
constexpr size_t SLAB = (size_t)256 * P_LD * 2 + (size_t)2 * 1536 * 128 * 2;
constexpr size_t SCR_HID = 0;
constexpr size_t SCR_P = 0, SCR_VT = (size_t)256 * P_LD * 2;
constexpr size_t SCR_QF = 0, SCR_C2 = (size_t)256 * QF_LD * 2;
static_assert(SCR_C2 + (size_t)256 * C2_LD * 2 <= SLAB && (size_t)256 * HID_LD * 2 <= SLAB, "slab too small");
constexpr size_t SCR_SZ = SLAB * NCU;
constexpr size_t WS_BAR = WS_SCR + SCR_SZ;
constexpr size_t WS_END = WS_BAR + 256;

struct Params { const float* in[26]; float* out; unsigned char* ws; };

#define GAS __attribute__((address_space(1)))
template <class T> __device__ __forceinline__ T gld(const void* p) { return *(const GAS T*)p; }
template <class T> __device__ __forceinline__ void gst(void* p, T v) { *(GAS T*)p = v; }
template <class T> __device__ __forceinline__ T* as_global(T* p) { return (T*)(__attribute__((address_space(1))) T*)p; }
__device__ __forceinline__ unsigned cvtpk(float lo, float hi) { unsigned r; asm volatile("v_cvt_pk_bf16_f32 %0, %1, %2" : "=v"(r) : "v"(lo), "v"(hi)); return r; }
__device__ __forceinline__ float bflo(unsigned w) { return __uint_as_float(w << 16); }
__device__ __forceinline__ float bfhi(unsigned w) { return __uint_as_float(w & 0xffff0000u); }
__device__ __forceinline__ bf16_t f2bf(float f) { return (bf16_t)(cvtpk(f, f) & 0xffffu); }
__device__ __forceinline__ float silu_f(float g) { return g * __builtin_amdgcn_rcpf(1.f + __expf(-g)); }
__device__ __forceinline__ float gelu_f(float x) { const float z = 1.5957691216057308f * (x + 0.044715f * x * x * x); return x * __builtin_amdgcn_rcpf(1.f + __expf(-z)); }
__device__ __forceinline__ f32x4 gelu4(f32x4 a, float r) {
    const f32x4 v = a * r, q = v * v; f32x4 e = v * (q * -0.10294324f + -2.30220819f);
    e[0] = __builtin_amdgcn_exp2f(e[0]); e[1] = __builtin_amdgcn_exp2f(e[1]); e[2] = __builtin_amdgcn_exp2f(e[2]); e[3] = __builtin_amdgcn_exp2f(e[3]);
    f32x4 d = e + 1.0f;
    d[0] = __builtin_amdgcn_rcpf(d[0]); d[1] = __builtin_amdgcn_rcpf(d[1]); d[2] = __builtin_amdgcn_rcpf(d[2]); d[3] = __builtin_amdgcn_rcpf(d[3]);
    return v * d;
}
__device__ __forceinline__ float wave_sum(float v) {
#pragma unroll
    for (int o = 32; o > 0; o >>= 1) v += __shfl_xor(v, o, 64);
    return v;
}

constexpr int BK = 64, HALF = 128, HTB = HALF * BK * 2;
#ifndef SNAKE
#define SNAKE 1
#endif
__device__ __forceinline__ int lds_byte(int r, int c) { const int st = (r >> 4) * 2 + (c >> 5), rr = r & 15, cc = c & 31, ob = rr * 64 + cc * 2; return st * 1024 + (ob ^ (((ob >> 9) & 1) << 5)); }
__device__ __forceinline__ void stage_rc(int b, int& R, int& C) { const int st = b / 1024, sb = b % 1024, swz = sb ^ (((sb >> 9) & 1) << 5); R = (st >> 1) * 16 + swz / 64; C = (st & 1) * 32 + (swz % 64) / 2; }

struct GemmArgs { const bf16_t* A; size_t hstepA; int lda; const bf16_t* Bt; int K; int nN; };
typedef f32x4 Acc[2][2][4][2];

enum { EP_FFN1 = 0, EP_XUPD, EP_SGU_IN, EP_MLA_IN, EP_MLA_Q, EP_MEMKV };
struct Epi {
    int mode; int cu; float alpha; unsigned char* ws; float* out; float* st;

    __device__ __forceinline__ size_t grow(int ai, int rr) const { return (size_t)ai * TPROMPT + (size_t)cu * 128 + rr; }
    __device__ __forceinline__ size_t lrow(int ai, int rr) const { return (size_t)(ai * 128 + rr); }

    __device__ __forceinline__ void operator()(Acc& acc, int pn, int wr, int wc, int fr, int fq) const {
        asm volatile("" : "+v"(fr), "+v"(fq));
        unsigned char* const slab = ws + WS_SCR + (size_t)cu * SLAB;
        float* const st_rsx_ = st, *const st_rq_ = st + 512, *const st_xacc_ = st + 1024 + wc * 256, *const st_vacc_ = st + 2048 + wc * 256, *const st_qacc_ = st + 3072 + wc * 256;
        if (mode == EP_FFN1) {
            bf16_t* const o0 = (bf16_t*)(slab + SCR_HID); constexpr int ld0 = HID_LD; const float* const st_r = st_rsx_;
#pragma unroll
            for (int ai = 0; ai < 2; ++ai)
#pragma unroll
                for (int m = 0; m < 4; ++m) {
                    const int rr = wr * 64 + m * 16 + fr; const float r = st_r[ai * 128 + rr];
                    bf16_t* rowp = o0 + lrow(ai, rr) * (size_t)ld0 + pn * 128 + wc * 32 + fq * 8;
                    u32x4 w; const float c1 = -1.4426950408889634f * r, r2 = r * r;
#pragma unroll
                    for (int n = 0; n < 2; ++n) {
                        const f32x4 g = acc[ai][0][m][n], u = acc[ai][1][m][n];
                        f32x4 e = g * c1;
                        e[0] = __builtin_amdgcn_exp2f(e[0]); e[1] = __builtin_amdgcn_exp2f(e[1]); e[2] = __builtin_amdgcn_exp2f(e[2]); e[3] = __builtin_amdgcn_exp2f(e[3]);
                        f32x4 d = e + 1.0f;
                        d[0] = __builtin_amdgcn_rcpf(d[0]); d[1] = __builtin_amdgcn_rcpf(d[1]); d[2] = __builtin_amdgcn_rcpf(d[2]); d[3] = __builtin_amdgcn_rcpf(d[3]);
                        const f32x4 h = (g * u) * (d * r2);
                        w[2 * n] = cvtpk(h[0], h[1]); w[2 * n + 1] = cvtpk(h[2], h[3]);
                    }
                    gst<u32x4>(rowp, w);
                }
        } else if (mode == EP_XUPD) {
            bf16_t* const x = (bf16_t*)out; float* const st_acc = st_xacc_;
#pragma unroll
            for (int ai = 0; ai < 2; ++ai)
#pragma unroll
                for (int m = 0; m < 4; ++m) {
                    const int rr = wr * 64 + m * 16 + fr;
                    bf16_t* rowp = x + grow(ai, rr) * (size_t)XLD + pn * 256 + wc * 32 + fq * 8;
                    float ss = 0.f;
#pragma unroll
                    for (int bj = 0; bj < 2; ++bj) {
                        bf16_t* p = rowp + bj * 128;
                        const u32x4 h = gld<u32x4>(p); u32x4 l = {0u, 0u, 0u, 0u}; if (XLO) l = gld<u32x4>(p + 1024);
                        u32x4 nh, nl;
#pragma unroll
                        for (int n = 0; n < 2; ++n) {
                            const f32x4 a = acc[ai][bj][m][n];
                            const float x0 = bflo(h[2 * n]) + bflo(l[2 * n]) + alpha * a[0], x1 = bfhi(h[2 * n]) + bfhi(l[2 * n]) + alpha * a[1];
                            const float x2 = bflo(h[2 * n + 1]) + bflo(l[2 * n + 1]) + alpha * a[2], x3 = bfhi(h[2 * n + 1]) + bfhi(l[2 * n + 1]) + alpha * a[3];
                            ss += x0 * x0 + x1 * x1 + x2 * x2 + x3 * x3;
                            nh[2 * n] = cvtpk(x0, x1); nh[2 * n + 1] = cvtpk(x2, x3);
                            if (XLO) { nl[2 * n] = cvtpk(x0 - bflo(nh[2 * n]), x1 - bfhi(nh[2 * n])); nl[2 * n + 1] = cvtpk(x2 - bflo(nh[2 * n + 1]), x3 - bfhi(nh[2 * n + 1])); }
                        }
                        gst<u32x4>(p, nh); if (XLO) gst<u32x4>(p + 1024, nl);
                    }
                    ss += __shfl_xor(ss, 16, 64); ss += __shfl_xor(ss, 32, 64);
                    if (fq == 0) st_acc[ai * 128 + rr] += ss;
                }
        } else if (mode == EP_SGU_IN) {
            bf16_t* const o0 = (bf16_t*)(slab + SCR_P); constexpr int ld0 = P_LD; const float* const st_r = st_rsx_; float* const st_acc = st_vacc_;
            bf16_t* const vt = (bf16_t*)(slab + SCR_VT);
            if (pn < 8) {
#pragma unroll
                for (int ai = 0; ai < 2; ++ai)
#pragma unroll
                    for (int m = 0; m < 4; ++m) {
                        const int rr = wr * 64 + m * 16 + fr; const float r = st_r[ai * 128 + rr];
                        bf16_t* rowp = o0 + lrow(ai, rr) * (size_t)ld0 + pn * 256 + wc * 32 + fq * 8;
#pragma unroll
                        for (int bj = 0; bj < 2; ++bj) {
                            u32x4 w;
#pragma unroll
                            for (int n = 0; n < 2; ++n) {
                                const f32x4 v = (pn < 6) ? gelu4(acc[ai][bj][m][n], r) : acc[ai][bj][m][n] * r;
                                w[2 * n] = cvtpk(v[0], v[1]); w[2 * n + 1] = cvtpk(v[2], v[3]);
                            }
                            gst<u32x4>(rowp + bj * 128, w);
                        }
                    }
            } else {
#pragma unroll
                for (int ai = 0; ai < 2; ++ai)
#pragma unroll
                    for (int m = 0; m < 4; ++m) {
                        const int rr = wr * 64 + m * 16 + fr; const float r = st_r[ai * 128 + rr];
                        bf16_t* colp = vt + ((size_t)ai * 1536 + (size_t)(pn - 8) * 256 + wc * 32 + fq * 8) * 128 + rr;
                        float ss = 0.f;
#pragma unroll
                        for (int bj = 0; bj < 2; ++bj)
#pragma unroll
                            for (int n = 0; n < 2; ++n) {
                                const f32x4 gv = gelu4(acc[ai][bj][m][n], r);
#pragma unroll
                                for (int i = 0; i < 4; ++i) { const float v = gv[i]; ss += v * v; gst<bf16_t>(colp + (size_t)(bj * 128 + n * 4 + i) * 128, f2bf(v)); }
                            }
                        ss += __shfl_xor(ss, 16, 64); ss += __shfl_xor(ss, 32, 64);
                        if (fq == 0) st_acc[ai * 128 + rr] += ss;
                    }
            }
        } else if (mode == EP_MLA_IN) {
            bf16_t* const c2 = (bf16_t*)(slab + SCR_C2); bf16_t* const o0 = c2; constexpr int ld0 = C2_LD, ldkv = C2_LD / 2; float* const kvraw = (float*)(c2 + 256);
            const float* const st_r = st_rsx_; float* const st_acc = st_qacc_;
            if (pn == 0) {
#pragma unroll
                for (int ai = 0; ai < 2; ++ai)
#pragma unroll
                    for (int m = 0; m < 4; ++m) {
                        const int rr = wr * 64 + m * 16 + fr; const float r = st_r[ai * 128 + rr];
                        bf16_t* rowp = o0 + lrow(ai, rr) * (size_t)ld0 + wc * 32 + fq * 8;
                        float ss = 0.f;
#pragma unroll
                        for (int bj = 0; bj < 2; ++bj)
#pragma unroll
                            for (int n = 0; n < 2; ++n) {
                                const f32x4 v = acc[ai][bj][m][n] * r;
                                ss += v[0] * v[0] + v[1] * v[1] + v[2] * v[2] + v[3] * v[3];
                                u32x2 w; w[0] = cvtpk(v[0], v[1]); w[1] = cvtpk(v[2], v[3]);
                                gst<u32x2>(rowp + bj * 128 + n * 4, w);
                            }
                        ss += __shfl_xor(ss, 16, 64); ss += __shfl_xor(ss, 32, 64);
                        if (fq == 0) st_acc[ai * 128 + rr] += ss;
                        __builtin_amdgcn_sched_barrier(0);
                    }
            } else if (pn == 1) {
#pragma unroll
                for (int ai = 0; ai < 2; ++ai)
#pragma unroll
                    for (int m = 0; m < 4; ++m) {
                        const int rr = wr * 64 + m * 16 + fr; const float r = st_r[ai * 128 + rr];
                        float* rowp = kvraw + lrow(ai, rr) * (size_t)ldkv + wc * 32 + fq * 8;
#pragma unroll
                        for (int n = 0; n < 2; ++n) {
                            gst<f32x4>(rowp + n * 4, acc[ai][0][m][n] * r);
                            if (wc < 2) gst<f32x4>(rowp + 128 + n * 4, acc[ai][1][m][n] * r);
                        }
                        __builtin_amdgcn_sched_barrier(0);
                    }
            } else {
#pragma unroll
                for (int ai = 0; ai < 2; ++ai)
#pragma unroll
                    for (int m = 0; m < 4; ++m) {
                        const int rr = wr * 64 + m * 16 + fr; const float r = st_r[ai * 128 + rr];
                        bf16_t* rowp = c2 + lrow(ai, rr) * (size_t)C2_LD + 1024 + (pn - 2) * 256 + wc * 32 + fq * 8;
#pragma unroll
                        for (int bj = 0; bj < 2; ++bj)
#pragma unroll
                            for (int n = 0; n < 2; ++n) {
                                const f32x4 v = acc[ai][bj][m][n] * r;
                                u32x2 w; w[0] = cvtpk(v[0], v[1]); w[1] = cvtpk(v[2], v[3]);
                                gst<u32x2>(rowp + bj * 128 + n * 4, w);
                            }
                        __builtin_amdgcn_sched_barrier(0);
                    }
            }
        } else if (mode == EP_MLA_Q) {
            bf16_t* const o0 = (bf16_t*)(slab + SCR_QF); constexpr int ld0 = QF_LD; const float* const st_r = st_rq_;
            const float* const rcos = (const float*)(ws + WS_ROPE); const float* const rsin = rcos + 16384 * 32;
            if (pn < 4) {
#pragma unroll
                for (int ai = 0; ai < 2; ++ai)
#pragma unroll
                    for (int m = 0; m < 4; ++m) {
                        const int rr = wr * 64 + m * 16 + fr; const float r = st_r[ai * 128 + rr];
                        bf16_t* rowp = o0 + lrow(ai, rr) * (size_t)ld0 + 2 * pn * 192 + wc * 32 + fq * 8;
#pragma unroll
                        for (int bj = 0; bj < 2; ++bj)
#pragma unroll
                            for (int n = 0; n < 2; ++n) {
                                const f32x4 v = acc[ai][bj][m][n] * r;
                                u32x2 w; w[0] = cvtpk(v[0], v[1]); w[1] = cvtpk(v[2], v[3]);
                                gst<u32x2>(rowp + bj * 192 + n * 4, w);
                            }
                        __builtin_amdgcn_sched_barrier(0);
                    }
            } else {
#pragma unroll
                for (int ai = 0; ai < 2; ++ai)
#pragma unroll
                    for (int m = 0; m < 4; ++m) {
                        const int rr = wr * 64 + m * 16 + fr; const float r = st_r[ai * 128 + rr];
                        const int pos = (cu * 128 + rr) & (ai ? 16383 : 8191);
                        bf16_t* rowp = o0 + lrow(ai, rr) * (size_t)ld0 + (4 * (pn - 4) + wc) * 192 + 128 + fq * 8;
                        const float* cp = rcos + pos * 32 + fq * 8; const float* sp = rsin + pos * 32 + fq * 8;
#pragma unroll
                        for (int n = 0; n < 2; ++n) {
                            const f32x4 c = gld<f32x4>(cp + n * 4), s = gld<f32x4>(sp + n * 4);
                            const f32x4 x1 = acc[ai][0][m][n] * r, x2 = acc[ai][1][m][n] * r;
                            const f32x4 y1 = x1 * c - x2 * s, y2 = x1 * s + x2 * c;
                            u32x2 w1, w2; w1[0] = cvtpk(y1[0], y1[1]); w1[1] = cvtpk(y1[2], y1[3]); w2[0] = cvtpk(y2[0], y2[1]); w2[1] = cvtpk(y2[2], y2[3]);
                            gst<u32x2>(rowp + n * 4, w1); gst<u32x2>(rowp + 32 + n * 4, w2);
                        }
                        __builtin_amdgcn_sched_barrier(0);
                    }
            }
        } else {
            const int pn0 = cu & 3; constexpr int ld0 = 1024;
            bf16_t* const o0 = (bf16_t*)(ws + WS_MEMKV) + ((size_t)(cu / 24) * 1536 + ((cu % 24) >> 2) * 256) * 1024;
#pragma unroll
            for (int ai = 0; ai < 2; ++ai)
#pragma unroll
                for (int m = 0; m < 4; ++m) {
                    bf16_t* rowp = o0 + (size_t)(ai * 128 + wr * 64 + m * 16 + fr) * ld0 + pn0 * 256 + wc * 32 + fq * 8;
#pragma unroll
                    for (int bj = 0; bj < 2; ++bj)
#pragma unroll
                        for (int n = 0; n < 2; ++n) {
                            const f32x4 v = acc[ai][bj][m][n];
                            u32x2 w; w[0] = cvtpk(v[0], v[1]); w[1] = cvtpk(v[2], v[3]);
                            gst<u32x2>(rowp + bj * 128 + n * 4, w);
                        }
                }
        }
    }
};

__device__ __forceinline__ void gemm_phase(LAS unsigned char* lds, const GemmArgs g, const Epi& E, const int tid) {
    const int wid = __builtin_amdgcn_readfirstlane(tid >> 6), lane = tid & 63, wr = wid >> 2, wc = wid & 3, fr = lane & 15, fq = lane >> 4;
    const int K = g.K, nt = K / BK;
    unsigned voffA[2], voffB[2];
#pragma unroll
    for (int i = 0; i < 2; ++i) { int R, C; stage_rc(tid * 16 + i * 8192, R, C); const int rho = R & 31, Rb = (R & ~31) + 8 * ((rho & 15) >> 2) + 4 * (rho >> 4) + (rho & 3);
        voffA[i] = (unsigned)(R * g.lda + C) * 2u; voffB[i] = (unsigned)(Rb * K + C) * 2u; }
    const size_t kstep = (size_t)(BK * 2);
    const size_t hstepB = (size_t)HALF * K * 2, tstepB = 2 * hstepB, hstepA = g.hstepA;
    const unsigned ldsw = (unsigned)wid * 1024u;
    const int aoff = lds_byte(wr * 64 + fr, fq * 8), boff = lds_byte(wc * 32 + fr, fq * 8);
#define PG8_SA(b, h) (((b) * 2 + (h)) * HTB)
#define PG8_SB(b, h) ((4 + (b) * 2 + (h)) * HTB)
#define PG8_STAGE(bufoff, gbase, voff) do { _Pragma("unroll") for (int _i = 0; _i < 2; ++_i) \
        __builtin_amdgcn_global_load_lds((const unsigned*)((const char*)(gbase) + (voff)[_i]), (LAS unsigned*)(lds + (bufoff) + ldsw + _i * 8192), 16, 0, 0); } while (0)
#define PG8_LDA(dst, b, h) do { _Pragma("unroll") for (int m = 0; m < 4; ++m) _Pragma("unroll") for (int k = 0; k < 2; ++k) dst[m][k] = *(const LAS bf16x8*)(lds + PG8_SA(b, h) + aoff + m * 2048 + k * 1024); } while (0)
#define PG8_LDB(dst, b, h) do { _Pragma("unroll") for (int n = 0; n < 2; ++n) _Pragma("unroll") for (int k = 0; k < 2; ++k) dst[n][k] = *(const LAS bf16x8*)(lds + PG8_SB(b, h) + boff + n * 2048 + k * 1024); } while (0)
#define PG8_MMA(ai, bj, At, Bt) do { __builtin_amdgcn_s_setprio(1); _Pragma("unroll") for (int m = 0; m < 4; ++m) _Pragma("unroll") for (int n = 0; n < 2; ++n) _Pragma("unroll") for (int k = 0; k < 2; ++k) \
        acc[ai][bj][m][n] = __builtin_amdgcn_mfma_f32_16x16x32_bf16(Bt[n][k], At[m][k], acc[ai][bj][m][n], 0, 0, 0); __builtin_amdgcn_s_setprio(0); } while (0)
#define PG8_WAIT_V(n) asm volatile("s_waitcnt vmcnt(" #n ")" ::: "memory")
#define PG8_WAIT_L(n) asm volatile("s_waitcnt lgkmcnt(" #n ")" ::: "memory")
#define PG8_BAR __builtin_amdgcn_s_barrier()
#define PG8_SCHED __builtin_amdgcn_sched_barrier(0)
    int ui = 0;
    Acc acc;
#pragma unroll
    for (int a = 0; a < 2; ++a)
#pragma unroll
        for (int b = 0; b < 2; ++b)
#pragma unroll
            for (int m = 0; m < 4; ++m)
#pragma unroll
                for (int n = 0; n < 2; ++n) acc[a][b][m][n] = (f32x4){0.f, 0.f, 0.f, 0.f};
    bf16x8 At[4][2], B0[2][2], B1[2][2];
    const ptrdiff_t KS = (ptrdiff_t)(BK * 2), lastoff = (ptrdiff_t)(nt - 1) * KS;
    const char* cA = (const char*)g.A; const char* cB = (const char*)g.Bt; ptrdiff_t ks = KS;
    PG8_STAGE(PG8_SB(0, 0), cB, voffB); PG8_STAGE(PG8_SA(0, 0), cA, voffA); PG8_STAGE(PG8_SB(0, 1), cB + hstepB, voffB); PG8_STAGE(PG8_SA(0, 1), cA + hstepA, voffA);
    if (wr == 1) PG8_BAR;
    PG8_WAIT_V(4); PG8_BAR;
    PG8_STAGE(PG8_SB(1, 0), cB + kstep, voffB); PG8_STAGE(PG8_SA(1, 0), cA + kstep, voffA); PG8_STAGE(PG8_SB(1, 1), cB + hstepB + kstep, voffB);
    PG8_WAIT_V(6); PG8_BAR;
    for (;;) {
        const bool has_next = (ui + 1 < g.nN);
        const bool nrev = SNAKE && (((ui + 1) & 1) != 0);
        const char* nA = has_next ? (const char*)g.A + (nrev ? lastoff : 0) : cA;
        const char* nB = has_next ? (const char*)g.Bt + (size_t)(ui + 1) * tstepB + (nrev ? lastoff : 0) : cB;
        const ptrdiff_t nks = has_next ? (nrev ? -KS : KS) : ks;
        for (int t = 0; t < nt; t += 2) {
            const bool last = (t == nt - 2);
            const char* a1 = cA + (ptrdiff_t)(t + 1) * ks;
            const char* a2 = last ? nA : cA + (ptrdiff_t)(t + 2) * ks; const char* b2 = last ? nB : cB + (ptrdiff_t)(t + 2) * ks;
            const ptrdiff_t k3 = last ? nks : ks;
            const char* a3 = a2 + k3; const char* b3 = b2 + k3;
            PG8_LDB(B0, 0, 0); PG8_SCHED; PG8_LDA(At, 0, 0); PG8_STAGE(PG8_SA(1, 1), a1 + hstepA, voffA);
            PG8_WAIT_L(8); PG8_BAR; PG8_WAIT_L(0); PG8_MMA(0, 0, At, B0); PG8_BAR; PG8_SCHED;
            PG8_LDB(B1, 0, 1); PG8_STAGE(PG8_SB(0, 0), b2, voffB);
            PG8_BAR; PG8_WAIT_L(0); PG8_MMA(0, 1, At, B1); PG8_BAR;
            PG8_LDA(At, 0, 1); PG8_STAGE(PG8_SA(0, 0), a2, voffA);
            PG8_BAR; PG8_WAIT_L(0); PG8_MMA(1, 0, At, B0); PG8_BAR; PG8_SCHED;
            PG8_STAGE(PG8_SB(0, 1), b2 + hstepB, voffB);
            PG8_WAIT_V(6); PG8_BAR; PG8_MMA(1, 1, At, B1); PG8_BAR;
            PG8_LDB(B0, 1, 0); PG8_SCHED; PG8_LDA(At, 1, 0); PG8_STAGE(PG8_SA(0, 1), a2 + hstepA, voffA);
            PG8_WAIT_L(8); PG8_BAR; PG8_WAIT_L(0); PG8_MMA(0, 0, At, B0); PG8_BAR; PG8_SCHED;
            PG8_LDB(B1, 1, 1); PG8_STAGE(PG8_SB(1, 0), b3, voffB);
            PG8_BAR; PG8_WAIT_L(0); PG8_MMA(0, 1, At, B1); PG8_BAR;
            PG8_LDA(At, 1, 1); PG8_STAGE(PG8_SA(1, 0), a3, voffA);
            PG8_BAR; PG8_WAIT_L(0); PG8_MMA(1, 0, At, B0); PG8_BAR; PG8_SCHED;
            PG8_STAGE(PG8_SB(1, 1), b3 + hstepB, voffB);
            PG8_WAIT_V(6); PG8_BAR; PG8_MMA(1, 1, At, B1); PG8_BAR;
        }
        E(acc, ui, wr, wc, fr, fq);
        if (!has_next) break;
#pragma unroll
        for (int a = 0; a < 2; ++a)
#pragma unroll
            for (int b = 0; b < 2; ++b)
#pragma unroll
                for (int m = 0; m < 4; ++m)
#pragma unroll
                    for (int n = 0; n < 2; ++n) acc[a][b][m][n] = (f32x4){0.f, 0.f, 0.f, 0.f};
        cA = nA; cB = nB; ks = nks; ++ui;
    }
    PG8_WAIT_V(0);
    if (wr == 0) PG8_BAR;
    PG8_BAR;
#undef PG8_SA
#undef PG8_SB
#undef PG8_STAGE
#undef PG8_LDA
#undef PG8_LDB
#undef PG8_MMA
#undef PG8_WAIT_V
#undef PG8_WAIT_L
#undef PG8_BAR
#undef PG8_SCHED
    __syncthreads();
}

#define KSWZ(row, colB) ((row) * 256 + ((colB) ^ (((row) & 15) << 4)))
#define KRSWZ(row, colB) ((row) * 128 + ((colB) ^ ((((row) >> 1) & 7) << 4)))
#define SBAR() __builtin_amdgcn_sched_barrier(0)
constexpr float ATT_THR = 8.f;
constexpr int SHM_V = 64 * 128 * 2, SHM_K = 64 * 128 * 2, SHM_KR = 64 * 64 * 2;
constexpr int AL_V = 0, AL_K = 2 * SHM_V, AL_KR = AL_K + 2 * SHM_K, AL_WS = AL_KR + 2 * SHM_KR, AL_Q = AL_WS + 2048;
#ifndef MLA_DMA
#define MLA_DMA 1
#endif
#ifndef MLA_NQL
#define MLA_NQL 4
#endif
#ifndef MLA_SD
#define MLA_SD 1
#endif
constexpr int NQL = MLA_NQL;
static_assert(AL_Q + 8 * NQL * 1024 <= LDS_TAB, "attention LDS overflows into the statistics");
__device__ __forceinline__ int crow(int r, int hi) { return (r & 3) + 8 * (r >> 2) + 4 * hi; }

template <bool MLA> __device__ __forceinline__ void partialSM(f32x16& p0, f32x16& p1, float& m_reg, float& mn, float& alpha) {
    constexpr float SCALE = MLA ? 1.0f : 0.088388347648318440f;
    constexpr float C = SCALE * 1.4426950408889634f;
    float pmax = p0[0];
#pragma unroll
    for (int r = 1; r < 16; ++r) pmax = fmaxf(pmax, p0[r]);
#pragma unroll
    for (int r = 0; r < 16; ++r) pmax = fmaxf(pmax, p1[r]);
    { auto rr = __builtin_amdgcn_permlane32_swap(__float_as_uint(pmax), __float_as_uint(pmax), false, false);
      pmax = fmaxf(__uint_as_float(rr[0]), __uint_as_float(rr[1])); }
    if (__builtin_expect(__all(pmax - m_reg <= ATT_THR / SCALE), 1)) { mn = m_reg; alpha = 1.f; }
    else { mn = fmaxf(m_reg, pmax); alpha = __builtin_amdgcn_exp2f((m_reg - mn) * C); m_reg = mn; }
    const float mnC = -mn * C;
#pragma unroll
    for (int r = 0; r < 16; ++r) p0[r] = fmaf(p0[r], C, mnC);
#pragma unroll
    for (int r = 0; r < 16; ++r) p1[r] = fmaf(p1[r], C, mnC);
#pragma unroll
    for (int r = 0; r < 16; ++r) p0[r] = __builtin_amdgcn_exp2f(p0[r]);
}
__device__ __forceinline__ void finishSM(f32x16& p0, f32x16& p1, float alpha, float& l_reg, bf16x8& pa0, bf16x8& pa1, bf16x8& pa2, bf16x8& pa3) {
#pragma unroll
    for (int r = 0; r < 16; ++r) p1[r] = __builtin_amdgcn_exp2f(p1[r]);
    float ps = 0;
#pragma unroll
    for (int r = 0; r < 16; ++r) ps += p0[r];
#pragma unroll
    for (int r = 0; r < 16; ++r) ps += p1[r];
    { auto rr = __builtin_amdgcn_permlane32_swap(__float_as_uint(ps), __float_as_uint(ps), false, false);
      ps = __uint_as_float(rr[0]) + __uint_as_float(rr[1]); }
    l_reg = l_reg * alpha + ps;
#define PK4(P, BASE, OUT) do { unsigned a0 = cvtpk(P[BASE + 0], P[BASE + 1]), a1 = cvtpk(P[BASE + 2], P[BASE + 3]);   \
    unsigned b0 = cvtpk(P[BASE + 4], P[BASE + 5]), b1 = cvtpk(P[BASE + 6], P[BASE + 7]);                              \
    auto r0 = __builtin_amdgcn_permlane32_swap(a0, b0, false, false); auto r1 = __builtin_amdgcn_permlane32_swap(a1, b1, false, false); \
    u32x4 w = {r0[0], r1[0], r0[1], r1[1]}; OUT = *reinterpret_cast<bf16x8*>(&w); } while (0)
    PK4(p0, 0, pa0); PK4(p0, 8, pa1); PK4(p1, 0, pa2); PK4(p1, 8, pa3);
#undef PK4
}
template <bool MLA> __device__ __forceinline__ void qkt(f32x16& p0, f32x16& p1, const char* Ks, const char* KRs, const bf16x8* qr, const char* ql, int r32, int hi) {
    p0 = f32x16{}; p1 = f32x16{};
#pragma unroll
    for (int d0 = 0; d0 < 8; ++d0) { const int cb = (d0 * 16 + hi * 8) * 2;
        const bf16x8 b0 = *reinterpret_cast<const bf16x8*>(Ks + KSWZ(r32, cb));
        const bf16x8 b1 = *reinterpret_cast<const bf16x8*>(Ks + KSWZ(32 + r32, cb));
        const bf16x8 qq = (MLA && d0 >= 12 - NQL) ? *reinterpret_cast<const bf16x8*>(ql + (d0 - (12 - NQL)) * 1024) : qr[(MLA && d0 >= 12 - NQL) ? 0 : d0];
        p0 = __builtin_amdgcn_mfma_f32_32x32x16_bf16(b0, qq, p0, 0, 0, 0);
        p1 = __builtin_amdgcn_mfma_f32_32x32x16_bf16(b1, qq, p1, 0, 0, 0); }
    if constexpr (MLA) {
#pragma unroll
        for (int d0 = 0; d0 < 4; ++d0) { const int cb = (d0 * 16 + hi * 8) * 2;
            const bf16x8 b0 = *reinterpret_cast<const bf16x8*>(KRs + KRSWZ(r32, cb));
            const bf16x8 b1 = *reinterpret_cast<const bf16x8*>(KRs + KRSWZ(32 + r32, cb));
            const bf16x8 qq = (8 + d0 >= 12 - NQL) ? *reinterpret_cast<const bf16x8*>(ql + (8 + d0 - (12 - NQL)) * 1024) : qr[(8 + d0 >= 12 - NQL) ? 0 : 8 + d0];
            p0 = __builtin_amdgcn_mfma_f32_32x32x16_bf16(b0, qq, p0, 0, 0, 0);
            p1 = __builtin_amdgcn_mfma_f32_32x32x16_bf16(b1, qq, p1, 0, 0, 0); }
    }
}
__device__ __forceinline__ int v_st(int k, int c) { const int kk = (k & ~0xC) | ((k & 4) << 1) | ((k & 8) >> 1); return ((kk >> 3) * 4 + (c >> 5)) * 512 + ((kk & 7) * 32 + (c & 31)) * 2; }
__device__ __forceinline__ int v_rd_base(int lane) { return ((lane & 3) << 3) | (((lane >> 2) & 3) << 6) | (((lane >> 4) & 1) << 5) | (((lane >> 5) & 1) << 8); }
constexpr int v_rd_off(int d0, int ks, int half) { return d0 * 512 + ks * 4096 + half * 2048; }
template <int OFF> __device__ __forceinline__ s16x4 tr_read(int vb) {
    s16x4 r; asm volatile("ds_read_b64_tr_b16 %0, %1 offset:%2" : "=&v"(r) : "v"(vb), "i"(OFF) : "memory"); return r;
}
template <int D0> __device__ __forceinline__ void pv_one(f32x16& od, int vb, bf16x8 pa0, bf16x8 pa1, bf16x8 pa2, bf16x8 pa3) {
    const s16x4 l0 = tr_read<v_rd_off(D0, 0, 0)>(vb), h0 = tr_read<v_rd_off(D0, 0, 1)>(vb), l1 = tr_read<v_rd_off(D0, 1, 0)>(vb), h1 = tr_read<v_rd_off(D0, 1, 1)>(vb);
    const s16x4 l2 = tr_read<v_rd_off(D0, 2, 0)>(vb), h2 = tr_read<v_rd_off(D0, 2, 1)>(vb), l3 = tr_read<v_rd_off(D0, 3, 0)>(vb), h3 = tr_read<v_rd_off(D0, 3, 1)>(vb);
    asm volatile("s_waitcnt lgkmcnt(0)" ::: "memory"); SBAR();
#define PK(L, H) (bf16x8){L[0], L[1], L[2], L[3], H[0], H[1], H[2], H[3]}
    od = __builtin_amdgcn_mfma_f32_32x32x16_bf16(pa0, PK(l0, h0), od, 0, 0, 0);
    od = __builtin_amdgcn_mfma_f32_32x32x16_bf16(pa1, PK(l1, h1), od, 0, 0, 0);
    od = __builtin_amdgcn_mfma_f32_32x32x16_bf16(pa2, PK(l2, h2), od, 0, 0, 0);
    od = __builtin_amdgcn_mfma_f32_32x32x16_bf16(pa3, PK(l3, h3), od, 0, 0, 0);
#undef PK
}
__device__ __forceinline__ void pv_d0(f32x16* o, int vb, bf16x8 pa0, bf16x8 pa1, bf16x8 pa2, bf16x8 pa3) {
    pv_one<0>(o[0], vb, pa0, pa1, pa2, pa3); pv_one<1>(o[1], vb, pa0, pa1, pa2, pa3); pv_one<2>(o[2], vb, pa0, pa1, pa2, pa3); pv_one<3>(o[3], vb, pa0, pa1, pa2, pa3);
}

template <bool MLA, int ldq, int ldk, int ldo>
__device__ __forceinline__ void attn_body(const bf16_t* __restrict__ Qw, const bf16_t* __restrict__ Kg, const bf16_t* __restrict__ Vg, int seq,
                                          bf16_t* __restrict__ Ow, bool do_store, char* lds, const int tid) {
    constexpr int NQ = MLA ? 12 - NQL : 8;
    const int wid = tid >> 6, lane = tid & 63, r32 = lane & 31, hi = lane >> 5;
    char* V_lds = lds + AL_V; char* K_lds = lds + AL_K; char* KR_lds = lds + AL_KR;
    float* ws = (float*)(lds + AL_WS) + wid * 64; float* li_l = ws; float* al_l = ws + 32;
    float m_reg = -1e30f, l_reg = 0; f32x16 o[4] = {}; bf16x8 qr[NQ];
    const bf16_t* Ql = Qw + (size_t)r32 * ldq + hi * 8;
#pragma unroll
    for (int d0 = 0; d0 < NQ; ++d0) qr[d0] = gld<bf16x8>(Ql + d0 * 16);
    const char* ql = lds + AL_Q + wid * (NQL * 1024) + lane * 16;
    if constexpr (MLA) {
#pragma unroll
        for (int d0 = NQ; d0 < 12; ++d0) *(bf16x8*)(lds + AL_Q + wid * (NQL * 1024) + (d0 - NQ) * 1024 + lane * 16) = gld<bf16x8>(Ql + d0 * 16);
    }
    const int sr = tid >> 4, sc = (tid & 15) * 8, vst0 = v_st(sr, sc), vst1 = v_st(32 + sr, sc);
    const int rr_ = tid >> 3, rc_ = (tid & 7) * 8;
    const int vb0 = (int)(uintptr_t)V_lds + v_rd_base(lane);
    constexpr int SD = MLA ? MLA_SD : 2;
    struct { bf16x8 vs0, vs1, ks0, ks1; } sr_[SD];
#define SLOAD(i, k0) do { if constexpr (MLA) { \
        sr_[i].ks0 = gld<bf16x8>(&Kg[(size_t)((k0) + sr) * ldk + sc]); sr_[i].ks1 = gld<bf16x8>(&Kg[(size_t)((k0) + 32 + sr) * ldk + sc]); \
        sr_[i].vs0 = gld<bf16x8>(&Kg[(size_t)((k0) + rr_) * ldk + 128 + rc_]); \
    } else { \
        sr_[i].vs0 = gld<bf16x8>(&Vg[(size_t)((k0) + sr) * ldk + sc]); sr_[i].vs1 = gld<bf16x8>(&Vg[(size_t)((k0) + 32 + sr) * ldk + sc]); \
        sr_[i].ks0 = gld<bf16x8>(&Kg[(size_t)((k0) + sr) * ldk + sc]); sr_[i].ks1 = gld<bf16x8>(&Kg[(size_t)((k0) + 32 + sr) * ldk + sc]); } } while (0)
#define SWRITE(b, i) do { const int kc = sc * 2; if constexpr (MLA) { \
        *(bf16x8*)(V_lds + (b) * SHM_V + vst0) = sr_[i].ks0; *(bf16x8*)(V_lds + (b) * SHM_V + vst1) = sr_[i].ks1; \
        *(bf16x8*)(KR_lds + (b) * SHM_KR + KRSWZ(rr_, rc_ * 2)) = sr_[i].vs0; \
    } else { \
        *(bf16x8*)(V_lds + (b) * SHM_V + vst0) = sr_[i].vs0; *(bf16x8*)(V_lds + (b) * SHM_V + vst1) = sr_[i].vs1; } \
        *(bf16x8*)(K_lds + (b) * SHM_K + KSWZ(sr, kc)) = sr_[i].ks0; *(bf16x8*)(K_lds + (b) * SHM_K + KSWZ(32 + sr, kc)) = sr_[i].ks1; } while (0)
#define SWAIT() do { if constexpr (SD == 1) asm volatile("s_waitcnt vmcnt(0)" ::: "memory"); else if constexpr (MLA) asm volatile("s_waitcnt vmcnt(3)" ::: "memory"); else asm volatile("s_waitcnt vmcnt(4)" ::: "memory"); } while (0)
#define RESC(a) do { if (__any((a) < 1.f)) { if (hi == 0) al_l[r32] = (a); asm volatile("s_waitcnt lgkmcnt(0)" ::: "memory"); \
    _Pragma("unroll") for (int d = 0; d < 4; ++d) _Pragma("unroll") for (int r = 0; r < 16; ++r) o[d][r] *= al_l[crow(r, hi)]; } } while (0)
    f32x16 pA0, pA1, pB0, pB1; float mnA, mnB, alA, alB; bf16x8 pa0, pa1, pa2, pa3; const int NT = seq / 64;
    constexpr int SE = 0, SO = SD - 1;
    SLOAD(SE, 0); asm volatile("s_waitcnt vmcnt(0)" ::: "memory"); SWRITE(0, SE); __syncthreads();
    qkt<MLA>(pA0, pA1, K_lds, KR_lds, qr, ql, r32, hi); partialSM<MLA>(pA0, pA1, m_reg, mnA, alA);
    SLOAD(SO, 64); if constexpr (SD == 2) { if (2 < NT) SLOAD(SE, 128); }
    SWAIT(); SWRITE(1, SO); __syncthreads();
    for (int j = 1; j + 1 < NT; j += 2) {
        SBAR(); qkt<MLA>(pB0, pB1, K_lds + SHM_K, KR_lds + SHM_KR, qr, ql, r32, hi);
        finishSM(pA0, pA1, alA, l_reg, pa0, pa1, pa2, pa3); SBAR();
        SLOAD(SO, (j + SD) * 64); SBAR();
        pv_d0(o, vb0, pa0, pa1, pa2, pa3); partialSM<MLA>(pB0, pB1, m_reg, mnB, alB);
        __syncthreads(); SWAIT(); SWRITE(0, SE);
        RESC(alB); __syncthreads();
        SBAR(); qkt<MLA>(pA0, pA1, K_lds, KR_lds, qr, ql, r32, hi);
        finishSM(pB0, pB1, alB, l_reg, pa0, pa1, pa2, pa3); SBAR();
        if (SD == 1 || j + 3 < NT) SLOAD(SE, (j + 1 + SD) * 64); SBAR();
        pv_d0(o, vb0 + SHM_V, pa0, pa1, pa2, pa3); partialSM<MLA>(pA0, pA1, m_reg, mnA, alA);
        __syncthreads(); SWAIT(); SWRITE(1, SO);
        RESC(alA); __syncthreads();
    }
    SBAR(); qkt<MLA>(pB0, pB1, K_lds + SHM_K, KR_lds + SHM_KR, qr, ql, r32, hi);
    finishSM(pA0, pA1, alA, l_reg, pa0, pa1, pa2, pa3); SBAR();
    pv_d0(o, vb0, pa0, pa1, pa2, pa3); partialSM<MLA>(pB0, pB1, m_reg, mnB, alB);
    __syncthreads(); RESC(alB);
    finishSM(pB0, pB1, alB, l_reg, pa0, pa1, pa2, pa3); SBAR();
    pv_d0(o, vb0 + SHM_V, pa0, pa1, pa2, pa3);
    if (hi == 0) li_l[r32] = l_reg; asm volatile("s_waitcnt lgkmcnt(0)" ::: "memory");
    float rli[16];
#pragma unroll
    for (int r = 0; r < 16; ++r) rli[r] = __builtin_amdgcn_rcpf(li_l[crow(r, hi)]);
    if (do_store) {
#pragma unroll
        for (int r = 0; r < 16; ++r) { const int orow = crow(r, hi);
#pragma unroll
            for (int d0 = 0; d0 < 4; ++d0) gst<bf16_t>(Ow + (size_t)orow * ldo + d0 * 32 + r32, f2bf(o[d0][r] * rli[r])); }
    }
    __syncthreads();
#undef SLOAD
#undef SWRITE
#undef SWAIT
#undef RESC
}


constexpr int TB3 = 40960, AL3_WS = 3 * TB3;
static_assert(AL3_WS + 2048 <= LDS_ST, "DMA attention ring overflows into the statistics");
__device__ __forceinline__ void qkt12(f32x16& p0, f32x16& p1, const char* Ks, const char* KRs, const bf16x8* qr, int r32, int hi) {
    p0 = f32x16{}; p1 = f32x16{};
#pragma unroll
    for (int d0 = 0; d0 < 8; ++d0) { const int cb = (d0 * 16 + hi * 8) * 2;
        const bf16x8 b0 = *reinterpret_cast<const bf16x8*>(Ks + KSWZ(r32, cb));
        const bf16x8 b1 = *reinterpret_cast<const bf16x8*>(Ks + KSWZ(32 + r32, cb));
        p0 = __builtin_amdgcn_mfma_f32_32x32x16_bf16(b0, qr[d0], p0, 0, 0, 0);
        p1 = __builtin_amdgcn_mfma_f32_32x32x16_bf16(b1, qr[d0], p1, 0, 0, 0); }
#pragma unroll
    for (int d0 = 0; d0 < 4; ++d0) { const int cb = (d0 * 16 + hi * 8) * 2;
        const bf16x8 b0 = *reinterpret_cast<const bf16x8*>(KRs + KRSWZ(r32, cb));
        const bf16x8 b1 = *reinterpret_cast<const bf16x8*>(KRs + KRSWZ(32 + r32, cb));
        p0 = __builtin_amdgcn_mfma_f32_32x32x16_bf16(b0, qr[8 + d0], p0, 0, 0, 0);
        p1 = __builtin_amdgcn_mfma_f32_32x32x16_bf16(b1, qr[8 + d0], p1, 0, 0, 0); }
}
template <bool MLA, int ldq, int ldk, int ldo>
__device__ __forceinline__ void attn_dma(const bf16_t* __restrict__ Qw, const bf16_t* __restrict__ Kg, const bf16_t* __restrict__ Vg, int seq, bf16_t* __restrict__ Ow, bool do_store, char* lds, const int tid) {
    constexpr int RB = ldk * 2, NQ = MLA ? 12 : 8;
    const int wid = __builtin_amdgcn_readfirstlane(tid >> 6), lane = tid & 63, r32 = lane & 31, hi = lane >> 5;
    float* ws = (float*)(lds + AL3_WS) + wid * 64; float* li_l = ws; float* al_l = ws + 32;
    float m_reg = -1e30f, l_reg = 0; f32x16 o[4] = {}; bf16x8 qr[NQ];
    const bf16_t* Ql = Qw + (size_t)r32 * ldq + hi * 8;
#pragma unroll
    for (int d0 = 0; d0 < NQ; ++d0) qr[d0] = gld<bf16x8>(Ql + d0 * 16);
    unsigned voffK, voffV, voffR;
    { const int G = wid * 64 + lane, row = G >> 4, sl = G & 15; voffK = (unsigned)(row * RB + ((sl ^ (row & 15)) * 16)); }
    { const int G = wid * 64 + lane, sub = G >> 5, r = G & 31, kk = (sub >> 2) * 8 + (r >> 2), k = (kk & ~0xC) | ((kk & 4) << 1) | ((kk & 8) >> 1), c = (sub & 3) * 32 + (r & 3) * 8;
      voffV = (unsigned)(k * RB + c * 2); }
    { const int G = wid * 64 + lane, row = G >> 3, sl = G & 7; voffR = (unsigned)(row * RB + 256 + ((sl ^ ((row >> 1) & 7)) * 16)); }
    const int vrd = v_rd_base(lane);
    LAS unsigned char* ldsl = (LAS unsigned char*)lds;
#define DMA3(boff, t) do { const char* _tb = (const char*)Kg + (size_t)(t) * (64 * RB); const char* _tv = MLA ? _tb : (const char*)Vg + (size_t)(t) * (64 * RB); LAS unsigned char* _lb = ldsl + (boff) + wid * 1024; \
        __builtin_amdgcn_global_load_lds((const unsigned*)(_tb + voffK), (LAS unsigned*)(_lb), 16, 0, 0); \
        __builtin_amdgcn_global_load_lds((const unsigned*)(_tb + 32 * RB + voffK), (LAS unsigned*)(_lb + 8192), 16, 0, 0); \
        __builtin_amdgcn_global_load_lds((const unsigned*)(_tv + voffV), (LAS unsigned*)(_lb + 16384), 16, 0, 0); \
        __builtin_amdgcn_global_load_lds((const unsigned*)(_tv + 32 * RB + voffV), (LAS unsigned*)(_lb + 24576), 16, 0, 0); \
        if constexpr (MLA) __builtin_amdgcn_global_load_lds((const unsigned*)(_tb + voffR), (LAS unsigned*)(_lb + 32768), 16, 0, 0); } while (0)
#define QKT3(P0, P1, boff) do { if constexpr (MLA) qkt12(P0, P1, lds + (boff), lds + (boff) + 32768, qr, r32, hi); else qkt<false>(P0, P1, lds + (boff), nullptr, qr, nullptr, r32, hi); } while (0)
#define RESC3(a) do { if (__any((a) < 1.f)) { if (hi == 0) al_l[r32] = (a); asm volatile("s_waitcnt lgkmcnt(0)" ::: "memory"); \
    _Pragma("unroll") for (int d = 0; d < 4; ++d) _Pragma("unroll") for (int r = 0; r < 16; ++r) o[d][r] *= al_l[crow(r, hi)]; } } while (0)
#define VB3(boff) ((int)(uintptr_t)(lds + (boff) + 16384) + vrd)
    f32x16 pA0, pA1, pB0, pB1; float mnA, mnB, alA, alB; bf16x8 pa0, pa1, pa2, pa3; const int NT = seq / 64;
    int bp = 0, bc = TB3, bn = 2 * TB3;
    DMA3(0, 0); DMA3(TB3, 1);
    asm volatile("s_waitcnt vmcnt(0)" ::: "memory"); __syncthreads();
    QKT3(pA0, pA1, 0); partialSM<MLA>(pA0, pA1, m_reg, mnA, alA);
    for (int j = 1; j + 1 < NT; j += 2) {
        DMA3(bn, j + 1);
        QKT3(pB0, pB1, bc);
        finishSM(pA0, pA1, alA, l_reg, pa0, pa1, pa2, pa3);
        pv_d0(o, VB3(bp), pa0, pa1, pa2, pa3); partialSM<MLA>(pB0, pB1, m_reg, mnB, alB);
        asm volatile("s_waitcnt vmcnt(0)" ::: "memory"); __syncthreads();
        RESC3(alB);
        { const int t_ = bp; bp = bc; bc = bn; bn = t_; }
        if (j + 2 < NT) DMA3(bn, j + 2);
        QKT3(pA0, pA1, bc);
        finishSM(pB0, pB1, alB, l_reg, pa0, pa1, pa2, pa3);
        pv_d0(o, VB3(bp), pa0, pa1, pa2, pa3); partialSM<MLA>(pA0, pA1, m_reg, mnA, alA);
        asm volatile("s_waitcnt vmcnt(0)" ::: "memory"); __syncthreads();
        RESC3(alA);
        { const int t_ = bp; bp = bc; bc = bn; bn = t_; }
    }
    SBAR(); QKT3(pB0, pB1, bc);
    finishSM(pA0, pA1, alA, l_reg, pa0, pa1, pa2, pa3); SBAR();
    pv_d0(o, VB3(bp), pa0, pa1, pa2, pa3); partialSM<MLA>(pB0, pB1, m_reg, mnB, alB);
    RESC3(alB);
    finishSM(pB0, pB1, alB, l_reg, pa0, pa1, pa2, pa3); SBAR();
    pv_d0(o, VB3(bc), pa0, pa1, pa2, pa3);
    if (hi == 0) li_l[r32] = l_reg; asm volatile("s_waitcnt lgkmcnt(0)" ::: "memory");
    float rli[16];
#pragma unroll
    for (int r = 0; r < 16; ++r) rli[r] = __builtin_amdgcn_rcpf(li_l[crow(r, hi)]);
    if (do_store) {
#pragma unroll
    for (int r = 0; r < 16; ++r) { const int orow = crow(r, hi);
#pragma unroll
        for (int d0 = 0; d0 < 4; ++d0) gst<bf16_t>(Ow + (size_t)orow * ldo + d0 * 32 + r32, f2bf(o[d0][r] * rli[r])); }
    }
    __syncthreads();
#undef QKT3
#undef DMA3
#undef RESC3
#undef VB3
}

enum { MAP_PLAIN = 0, MAP_FFN_IN, MAP_SGU_IN, MAP_MLA_IN };
__device__ __forceinline__ int map_col(int mode, int n0) {
    if (mode == MAP_FFN_IN) { const int pn = n0 >> 8, w = n0 & 255; return (w >> 7) * DFF + pn * 128 + (w & 127); }
    if (mode == MAP_SGU_IN) { return n0 < 1536 ? n0 : (n0 < 2048 ? 3072 + (n0 - 1536) : 1536 + (n0 - 2048)); }
    if (mode == MAP_MLA_IN) { return n0 < 448 ? n0 : (n0 < 512 ? -1 : 448 + (n0 - 512)); }
    return n0;
}
__device__ __forceinline__ int cvtT(const float* __restrict__ src, int sld, int K, int N, bf16_t* __restrict__ dst, const float* __restrict__ gain, float scale, int mode, float* tile, const int tid, int& tnext, int tbase) {
    const int ntk = K / 64, ntn = N / 256, tx = tid & 63, ty = tid >> 6;
    for (; tnext < tbase + ntk * ntn; tnext += NCU) {
        const int t = tnext - tbase, nb = t / ntk, kb = t % ntk; const int sc = map_col(mode, nb * 256 + (tx >> 4) * 64);
        __syncthreads();
        f32x4 v[8];
#pragma unroll
        for (int ps = 0; ps < 8; ++ps) { v[ps] = (f32x4){0.f, 0.f, 0.f, 0.f}; if (sc >= 0) v[ps] = gld<f32x4>(src + (size_t)(kb * 64 + ps * 8 + ty) * sld + sc + (tx & 15) * 4); }
#pragma unroll
        for (int ps = 0; ps < 8; ++ps) { const int kk = ps * 8 + ty; const float g = gain ? gld<float>(gain + kb * 64 + kk) * scale : scale; *(f32x4*)(tile + kk * 260 + tx * 4) = v[ps] * g; }
        __syncthreads();
#pragma unroll
        for (int q = 0; q < 4; ++q) {
            const int item = q * 512 + tid, n = item & 255, k8 = (item >> 8) * 8;
            u32x4 w;
            w[0] = cvtpk(tile[(k8 + 0) * 260 + n], tile[(k8 + 1) * 260 + n]); w[1] = cvtpk(tile[(k8 + 2) * 260 + n], tile[(k8 + 3) * 260 + n]);
            w[2] = cvtpk(tile[(k8 + 4) * 260 + n], tile[(k8 + 5) * 260 + n]); w[3] = cvtpk(tile[(k8 + 6) * 260 + n], tile[(k8 + 7) * 260 + n]);
            gst<u32x4>(dst + (size_t)(nb * 256 + n) * K + kb * 64 + k8, w);
        }
    }
    return tbase + ntk * ntn;
}

enum { OP_PREP = 0, OP_GSYNC, OP_G_MEMKV, OP_G_FFN1, OP_G_FFN2, OP_G_SGU_IN, OP_MIX, OP_MEMATT, OP_G_SGU_OUT, OP_G_MLA_IN, OP_KVPOST, OP_G_MLA_Q, OP_MLA_ATT, OP_G_MLA_OUT, OP_FINAL };
#define PC(op, l, sub) (unsigned char)((op) | ((l) << 4) | ((sub) << 6))
#define SGU_LAYER(l) PC(OP_G_FFN1, l, 0), PC(OP_G_FFN2, l, 0), PC(OP_G_SGU_IN, l, 0), PC(OP_MIX, l, 0), PC(OP_MEMATT, l, 0), PC(OP_G_SGU_OUT, l, 0), PC(OP_G_FFN1, l, 1), PC(OP_G_FFN2, l, 1)
#define MLA_LAYER(l) PC(OP_G_FFN1, l, 0), PC(OP_G_FFN2, l, 0), PC(OP_G_MLA_IN, l, 0), PC(OP_KVPOST, l, 0), PC(OP_G_MLA_Q, l, 0), PC(OP_GSYNC, l, 0), PC(OP_MLA_ATT, l, 0), PC(OP_MEMATT, l, 0), PC(OP_G_MLA_OUT, l, 0), PC(OP_G_FFN1, l, 1), PC(OP_G_FFN2, l, 1)
__constant__ double ROPEC[17] = { 1.333521432163324, 0.6366197723675814, 1.5707963267948966, 6.123233995736766e-17,
    -1.0 / 6, 1.0 / 120, -1.0 / 5040, 1.0 / 362880, -1.0 / 39916800, 1.0 / 6227020800.0,
    -0.5, 1.0 / 24, -1.0 / 720, 1.0 / 40320, -1.0 / 3628800, 1.0 / 479001600.0, -1.0 / 87178291200.0 };
constexpr int NPROG = 46;
__constant__ unsigned char PROG[NPROG] = {
    PC(OP_PREP, 0, 0), PC(OP_GSYNC, 0, 0), PC(OP_G_MEMKV, 0, 0), PC(OP_GSYNC, 0, 0),
    SGU_LAYER(0), MLA_LAYER(1),
    PC(OP_GSYNC, 0, 0), PC(OP_PREP, 2, 0), PC(OP_GSYNC, 0, 0),
    SGU_LAYER(2), MLA_LAYER(3),
    PC(OP_FINAL, 0, 0) };

__global__ __launch_bounds__(512, 2) void fwd_megakernel(Params p) {
    extern __shared__ __attribute__((aligned(16))) unsigned char shm[];
    cg::grid_group grid = cg::this_grid();
    const int cu = blockIdx.x;
    LAS unsigned char* lds = (LAS unsigned char*)shm;
    float* st = (float*)(shm + LDS_ST);
    float* st_rsx = st, *st_rv = st + 256, *st_rq = st + 512, *st_xacc = st + 1024, *st_vacc = st + 2048, *st_qacc = st + 3072;
    float* tile = (float*)shm;
    const float** tab = (const float**)(shm + LDS_TAB);
    if (threadIdx.x < 26) tab[threadIdx.x] = p.in[threadIdx.x];
    __syncthreads();
#define PIN(i) as_global(((const float* volatile*)tab)[i])
    grid.sync();
    int nsync = 0;
    for (int pc = 0; pc < NPROG; ++pc) {
        int tid = threadIdx.x; asm volatile("" : "+v"(tid));
        const int wid = tid >> 6, lane = tid & 63;
        unsigned char* ws = p.ws; float* outp = p.out; asm volatile("" : "+s"(ws), "+s"(outp)); ws = as_global(ws); outp = as_global(outp);
        bf16_t* X = (bf16_t*)outp;
        unsigned char* slab = ws + WS_SCR + (size_t)cu * SLAB;
        bf16_t* HID = (bf16_t*)(slab + SCR_HID);
        bf16_t* Pb = (bf16_t*)(slab + SCR_P);
        bf16_t* VT = (bf16_t*)(slab + SCR_VT);
        bf16_t* QF = (bf16_t*)(slab + SCR_QF);
        bf16_t* C2 = (bf16_t*)(slab + SCR_C2);
        bf16_t* KB = (bf16_t*)(ws + WS_KBUF);
        bf16_t* MEMKV = (bf16_t*)(ws + WS_MEMKV);
        float* kvraw = (float*)(C2 + 256);
        const float* rcos = (const float*)(ws + WS_ROPE); const float* rsin = rcos + 16384 * 32;
        const size_t hstepTok = (size_t)TPROMPT * 2;
        const size_t hstepLoc = (size_t)128 * 2;

#ifdef RUN_UNTIL
        if (pc >= RUN_UNTIL && pc != NPROG - 1) continue;
#endif
        const int code = PROG[pc], op = code & 15, l = (code >> 4) & 3, sub = (code >> 6) & 1, dup = code >> 7, j = l >> 1;
        unsigned char* slot = ws + ((l & 1) ? WS_SLOTB : WS_SLOTA);
        const bool is_gemm = (op == OP_G_MEMKV || op == OP_G_FFN1 || op == OP_G_FFN2 || op == OP_G_SGU_IN || op == OP_G_SGU_OUT || op == OP_G_MLA_IN || op == OP_G_MLA_Q || op == OP_G_MLA_OUT);
        if (is_gemm) {
            GemmArgs g{}; Epi e{}; e.cu = cu; e.ws = ws; e.out = outp; e.st = st; e.alpha = 1.f; bool run = true;
            if (op == OP_G_MEMKV) {
                run = cu < 96; const int ll = cu / 24, rem = cu % 24, rb = rem >> 2, pn = rem & 3;
                g.A = (const bf16_t*)(ws + WS_MEMN) + (size_t)rb * 256 * 1024; g.hstepA = (size_t)128 * 1024 * 2; g.lda = 1024;
                g.Bt = (const bf16_t*)(ws + WS_MEMW) + ((size_t)ll * 1024 + pn * 256) * 1024; g.K = 1024; g.nN = 1;
                e.mode = EP_MEMKV;
            } else if (op == OP_G_FFN1) {
                g.A = X + (size_t)cu * 128 * XLD; g.hstepA = hstepTok * XLD; g.lda = XLD; g.Bt = (const bf16_t*)(slot + (sub == 0 ? SL_F1I : SL_F2I)); g.K = 1024; g.nN = 22;
                e.mode = EP_FFN1;
            } else if (op == OP_G_FFN2) {
                g.A = HID; g.hstepA = hstepLoc * HID_LD; g.lda = HID_LD; g.Bt = (const bf16_t*)(slot + (sub == 0 ? SL_F1O : SL_F2O)); g.K = 2816; g.nN = 4;
                e.mode = EP_XUPD; e.alpha = dup ? 0.f : 0.5f;
            } else if (op == OP_G_SGU_IN) {
                g.A = X + (size_t)cu * 128 * XLD; g.hstepA = hstepTok * XLD; g.lda = XLD; g.Bt = (const bf16_t*)(slot + SG_IN); g.K = 1024; g.nN = 14;
                e.mode = EP_SGU_IN;
                if (tid < 256) { st_vacc[tid] = 0.f; st_vacc[256 + tid] = 0.f; st_vacc[512 + tid] = 0.f; st_vacc[768 + tid] = 0.f; }
            } else if (op == OP_G_SGU_OUT) {
                g.A = Pb; g.hstepA = hstepLoc * P_LD; g.lda = P_LD; g.Bt = (const bf16_t*)(slot + SG_OUT); g.K = 2048; g.nN = 4;
                e.mode = EP_XUPD; e.alpha = 1.0f;
            } else if (op == OP_G_MLA_IN) {
                g.A = X + (size_t)cu * 128 * XLD; g.hstepA = hstepTok * XLD; g.lda = XLD; g.Bt = (const bf16_t*)(slot + ML_IN); g.K = 1024; g.nN = 4;
                e.mode = EP_MLA_IN;
                if (tid < 256) { st_qacc[tid] = 0.f; st_qacc[256 + tid] = 0.f; st_qacc[512 + tid] = 0.f; st_qacc[768 + tid] = 0.f; }
            } else if (op == OP_G_MLA_Q) {
                g.A = C2; g.hstepA = hstepLoc * C2_LD; g.lda = C2_LD; g.Bt = (const bf16_t*)(slot + ML_Q); g.K = 256; g.nN = 6;
                e.mode = EP_MLA_Q;
            } else {
                g.A = C2; g.hstepA = hstepLoc * C2_LD; g.lda = C2_LD; g.Bt = (const bf16_t*)(slot + ML_OUT); g.K = 1536; g.nN = 4;
                e.mode = EP_XUPD; e.alpha = 1.0f;
            }
            __syncthreads();
            if (run) gemm_phase(lds, g, e, tid);
            if (tid < 256) {
                if (e.mode == EP_XUPD) { st_rsx[tid] = rsqrtf(((st_xacc[tid] + st_xacc[256 + tid]) + (st_xacc[512 + tid] + st_xacc[768 + tid])) * (1.f / 1024.f) + EPS); st_xacc[tid] = 0.f; st_xacc[256 + tid] = 0.f; st_xacc[512 + tid] = 0.f; st_xacc[768 + tid] = 0.f; }
                else if (e.mode == EP_SGU_IN) st_rv[tid] = rsqrtf(((st_vacc[tid] + st_vacc[256 + tid]) + (st_vacc[512 + tid] + st_vacc[768 + tid])) * (1.f / 1536.f) + EPS);
                else if (e.mode == EP_MLA_IN) st_rq[tid] = rsqrtf(((st_qacc[tid] + st_qacc[256 + tid]) + (st_qacc[512 + tid] + st_qacc[768 + tid])) * (1.f / 256.f) + EPS);
            }
            __syncthreads();
        } else if (op == OP_GSYNC) {
            __builtin_amdgcn_fence(__ATOMIC_RELEASE, "agent"); asm volatile("s_waitcnt vmcnt(0) lgkmcnt(0)" ::: "memory");
            __syncthreads();
            ++nsync;
            if (tid == 0) {
                unsigned* bar = (unsigned*)(ws + WS_BAR);
                __hip_atomic_fetch_add(bar, 1u, __ATOMIC_RELAXED, __HIP_MEMORY_SCOPE_AGENT);
                while (__hip_atomic_load(bar, __ATOMIC_RELAXED, __HIP_MEMORY_SCOPE_AGENT) < (unsigned)(NCU * nsync)) __builtin_amdgcn_s_sleep(4);
            }
            __syncthreads();
            __builtin_amdgcn_fence(__ATOMIC_ACQUIRE, "agent"); asm volatile("s_waitcnt vmcnt(0) lgkmcnt(0)" ::: "memory");
            __syncthreads();
        } else if (op == OP_PREP) {
            const int nitems = (l == 0) ? 16 : 12; int tnext = cu, tbase = 0;
            for (int item = 0; item < nitems; ++item) {
                const float* src; int sld, K, N, mode = MAP_PLAIN; bf16_t* dst; const float* gain = nullptr; bool skip = false;
                if (item < 12) {
                    const int ll = l + item / 6, m = item % 6; unsigned char* sl = ws + ((ll & 1) ? WS_SLOTB : WS_SLOTA); const int jj = ll >> 1;
                    if (m == 0 || m == 2) { src = PIN(m == 0 ? 5 : 11) + (size_t)ll * 1024 * 5632; sld = 5632; K = 1024; N = 5632; dst = (bf16_t*)(sl + (m == 0 ? SL_F1I : SL_F2I)); gain = PIN(m == 0 ? 4 : 10) + ll * 1024; mode = MAP_FFN_IN; }
                    else if (m == 1 || m == 3) { src = PIN(m == 1 ? 6 : 12) + (size_t)ll * 2816 * 1024; sld = 1024; K = 2816; N = 1024; dst = (bf16_t*)(sl + (m == 1 ? SL_F1O : SL_F2O)); }
                    else if (m == 4) {
                        if ((ll & 1) == 0) { src = PIN(13) + (size_t)jj * 1024 * 3584; sld = 3584; K = 1024; N = 3584; dst = (bf16_t*)(sl + SG_IN); gain = PIN(7) + ll * 1024; mode = MAP_SGU_IN; }
                        else { src = PIN(18) + (size_t)jj * 1024 * 960; sld = 960; K = 1024; N = 1024; dst = (bf16_t*)(sl + ML_IN); gain = PIN(7) + ll * 1024; mode = MAP_MLA_IN; }
                    } else {
                        if ((ll & 1) == 0) { src = PIN(17) + (size_t)jj * 2048 * 1024; sld = 1024; K = 2048; N = 1024; dst = (bf16_t*)(sl + SG_OUT); }
                        else { skip = true; src = nullptr; sld = K = N = 64; dst = nullptr; }
                    }
                } else { const int ll = item - 12; src = PIN(9) + (size_t)ll * 1024 * 1024; sld = 1024; K = 1024; N = 1024; dst = (bf16_t*)(ws + WS_MEMW) + (size_t)ll * 1024 * 1024; gain = PIN(8) + ll * 1024; }
                if (!skip) tbase = cvtT(src, sld, K, N, dst, gain, 1.f, mode, tile, tid, tnext, tbase);
            }
            __syncthreads();
            const size_t gt = (size_t)cu * NTHR + tid, gn = (size_t)NCU * NTHR;
            {
                const int jj = l >> 1; const float* wsp = PIN(15) + (size_t)jj * 8 * 128 * 128; bf16_t* d = (bf16_t*)(ws + WS_SLOTA + SG_WS);
                for (size_t i = gt; i < (size_t)8 * 128 * 128; i += gn) d[i] = f2bf(wsp[i]);
            }
            {
                const int jj = l >> 1; unsigned char* sl = ws + WS_SLOTB;
                const float* wuq = PIN(20) + (size_t)jj * 256 * 1536; const float* wuk = PIN(22) + (size_t)jj * 128 * 8 * 128; const float* qn = PIN(19) + jj * 256;
                bf16_t* dq = (bf16_t*)(sl + ML_Q); const float qs = 0.07216878364870322f;
                for (size_t i = gt; i < (size_t)1536 * 256; i += gn) {
                    const int n = (int)(i >> 8), k = (int)(i & 255); float v;
                    if (n < 1024) { const int h = n >> 7, c = n & 127; const float* a = wuq + (size_t)k * 1536 + h * 192; const float* b = wuk + ((size_t)c * 8 + h) * 128; float sacc = 0.f;
                        for (int d = 0; d < 128; d += 4) { const f32x4 x = *(const f32x4*)(a + d), y = *(const f32x4*)(b + d); sacc += x[0] * y[0] + x[1] * y[1] + x[2] * y[2] + x[3] * y[3]; } v = sacc; }
                    else { const int rem = n - 1024, t = rem >> 8, w = rem & 255, half = w >> 7, hh = (w & 127) >> 5, j2 = w & 31; v = wuq[(size_t)k * 1536 + (4 * t + hh) * 192 + 128 + 32 * half + j2]; }
                    dq[i] = f2bf(v * qn[k] * qs);
                }
                const float* wuv = PIN(23) + (size_t)jj * 128 * 8 * 128; const float* wo = PIN(24) + (size_t)jj * 1536 * 1024; bf16_t* dout = (bf16_t*)(sl + ML_OUT);
                for (size_t i = gt; i < (size_t)8 * 64 * 256; i += gn) {
                    const int n = (int)(i & 255) * 4, c = (int)((i >> 8) & 63) * 2, h = (int)(i >> 14);
                    const float* a0 = wuv + ((size_t)c * 8 + h) * 128; const float* a1 = a0 + 8 * 128; const float* b = wo + (size_t)(h * 128) * 1024 + n;
                    f32x4 s0 = {0.f, 0.f, 0.f, 0.f}, s1 = {0.f, 0.f, 0.f, 0.f};
#pragma unroll 8
                    for (int d = 0; d < 128; ++d) { const f32x4 bv = *(const f32x4*)(b + (size_t)d * 1024); s0 += bv * a0[d]; s1 += bv * a1[d]; }
                    const int kk = h * 128 + c;
#pragma unroll
                    for (int q = 0; q < 4; ++q) *(unsigned*)(dout + (size_t)(n + q) * 1536 + kk) = cvtpk(s0[q], s1[q]);
                }
                for (size_t i = gt; i < (size_t)512 * 256; i += gn) {
                    const int kk = 1024 + (int)(i >> 8), n = (int)(i & 255) * 4; const f32x4 v = *(const f32x4*)(wo + (size_t)kk * 1024 + n);
#pragma unroll
                    for (int q = 0; q < 4; ++q) dout[(size_t)(n + q) * 1536 + kk] = f2bf(v[q]);
                }
            }
            if (l == 0) {
                {
                    bf16_t* memn = (bf16_t*)(ws + WS_MEMN);
                    for (int r = cu * 8 + wid; r < 1536; r += NCU * 8) {
                        const float* src = r < 1024 ? PIN(2) + (size_t)r * 1024 : PIN(3) + (size_t)(r - 1024) * 1024;
                        f32x4 v[4]; float ss = 0.f;
#pragma unroll
                        for (int q = 0; q < 4; ++q) { v[q] = *(const f32x4*)(src + q * 256 + lane * 4); ss += v[q][0] * v[q][0] + v[q][1] * v[q][1] + v[q][2] * v[q][2] + v[q][3] * v[q][3]; }
                        ss = wave_sum(ss); const float rs = rsqrtf(ss * (1.f / 1024.f) + EPS);
#pragma unroll
                        for (int q = 0; q < 4; ++q) { u32x2 w; w[0] = cvtpk(v[q][0] * rs, v[q][1] * rs); w[1] = cvtpk(v[q][2] * rs, v[q][3] * rs); *(u32x2*)(memn + (size_t)r * 1024 + q * 256 + lane * 4) = w; }
                    }
                }
                {
                    float* c = (float*)(ws + WS_ROPE); float* s = c + 16384 * 32;
                    for (int i = cu * NTHR + tid; i < 16384 * 32; i += NCU * NTHR) {
                        const int pos = i >> 5, jj = i & 31;
                        const volatile double* rc = ROPEC;
                        const double cB = rc[0];
                        double bp = 1.0; for (int t = 0; t < jj; ++t) bp *= cB;
                        const float invf = 1.0f / (float)bp;
                        const float ang = (float)pos * invf;
                        const double ad = (double)ang, kq = rint(ad * rc[1]);
                        const double r = (ad - kq * rc[2]) - kq * rc[3], r2 = r * r;
                        const double sr = r * (1.0 + r2 * (rc[4] + r2 * (rc[5] + r2 * (rc[6] + r2 * (rc[7] + r2 * (rc[8] + r2 * rc[9]))))));
                        const double cr = 1.0 + r2 * (rc[10] + r2 * (rc[11] + r2 * (rc[12] + r2 * (rc[13] + r2 * (rc[14] + r2 * (rc[15] + r2 * rc[16]))))));
                        const int qd = ((int)kq) & 3;
                        const double sd = (qd == 0) ? sr : (qd == 1) ? cr : (qd == 2) ? -sr : -cr;
                        const double cd = (qd == 0) ? cr : (qd == 1) ? -sr : (qd == 2) ? -cr : sr;
                        c[i] = (float)cd; s[i] = (float)sd;
                    }
                }
                {
                    const float* xin0 = PIN(0); const float* xin1 = PIN(1);
                    for (int it = 0; it < 8; ++it) {
                        f32x4 v[4][4];
#pragma unroll
                        for (int u = 0; u < 4; ++u) { const int rr = wid + 8 * (4 * it + u), ai = rr >> 7, pr = rr & 127; const float* src = (ai ? xin1 : xin0) + ((size_t)cu * 128 + pr) * 1024;
#pragma unroll
                            for (int q = 0; q < 4; ++q) v[u][q] = gld<f32x4>(src + q * 256 + lane * 4); }
#pragma unroll
                        for (int u = 0; u < 4; ++u) { const int rr = wid + 8 * (4 * it + u), ai = rr >> 7, pr = rr & 127;
                            bf16_t* dst = X + ((size_t)ai * TPROMPT + (size_t)cu * 128 + pr) * XLD; float ss = 0.f;
#pragma unroll
                            for (int q = 0; q < 4; ++q) ss += v[u][q][0] * v[u][q][0] + v[u][q][1] * v[u][q][1] + v[u][q][2] * v[u][q][2] + v[u][q][3] * v[u][q][3];
                            ss = wave_sum(ss);
#pragma unroll
                            for (int q = 0; q < 4; ++q) {
                                u32x2 h, lo; h[0] = cvtpk(v[u][q][0], v[u][q][1]); h[1] = cvtpk(v[u][q][2], v[u][q][3]);
                                gst<u32x2>(dst + q * 256 + lane * 4, h);
                                if (XLO) { lo[0] = cvtpk(v[u][q][0] - bflo(h[0]), v[u][q][1] - bfhi(h[0])); lo[1] = cvtpk(v[u][q][2] - bflo(h[1]), v[u][q][3] - bfhi(h[1])); gst<u32x2>(dst + 1024 + q * 256 + lane * 4, lo); }
                            }
                            if (lane == 0) st_rsx[rr] = rsqrtf(ss * (1.f / 1024.f) + EPS);
                        }
                    }
                    if (tid < 256) { st_xacc[tid] = 0.f; st_xacc[256 + tid] = 0.f; st_xacc[512 + tid] = 0.f; st_xacc[768 + tid] = 0.f; }
                }
            }
        } else if (op == OP_MIX) {
#ifndef NO_MIX
            const int gi = wid, fr = lane & 15, fq = lane >> 4;
            const bf16_t* Wsg = (const bf16_t*)(slot + SG_WS) + (size_t)gi * 128 * 128;
            const float* vgain = PIN(14) + j * 1536 + gi * 192; const float* bs = PIN(16) + (size_t)j * 8 * 128 + gi * 128;
            for (int ai = 0; ai < 2; ++ai) {
                bf16x8 bw[8][4];
#pragma unroll
                for (int ks = 0; ks < 4; ++ks) {
                    float rv8[8];
#pragma unroll
                    for (int i = 0; i < 8; ++i) rv8[i] = st_rv[ai * 128 + ks * 32 + fq * 8 + i];
#pragma unroll
                    for (int pb = 0; pb < 8; ++pb) {
                        const u32x4 raw = gld<u32x4>(Wsg + (size_t)(pb * 16 + fr) * 128 + ks * 32 + fq * 8);
                        u32x4 w;
#pragma unroll
                        for (int i = 0; i < 4; ++i) w[i] = cvtpk(bflo(raw[i]) * rv8[2 * i], bfhi(raw[i]) * rv8[2 * i + 1]);
                        bw[pb][ks] = *reinterpret_cast<bf16x8*>(&w);
                    }
                    __builtin_amdgcn_sched_barrier(0);
                }
                const bf16_t* vtg = VT + ((size_t)ai * 1536 + gi * 192) * 128;
                bf16_t* const ubase = Pb + (size_t)(ai * 128 + fr) * P_LD + gi * 192 + fq * 4;
                for (int cb = 0; cb < 12; ++cb) {
                    bf16x8 af[4];
#pragma unroll
                    for (int ks = 0; ks < 4; ++ks) af[ks] = gld<bf16x8>(vtg + (size_t)(cb * 16 + fr) * 128 + ks * 32 + fq * 8);
                    const f32x4 gn = gld<f32x4>(vgain + cb * 16 + fq * 4);
#pragma unroll
                    for (int ph = 0; ph < 2; ++ph) {
                        u32x2 uw[4];
#pragma unroll
                        for (int pb = 0; pb < 4; ++pb) uw[pb] = gld<u32x2>(ubase + (size_t)((ph * 4 + pb) * 16) * P_LD + cb * 16);
#pragma unroll
                        for (int pb = 0; pb < 4; ++pb) {
                            f32x4 d = {0.f, 0.f, 0.f, 0.f};
#pragma unroll
                            for (int ks = 0; ks < 4; ++ks) d = __builtin_amdgcn_mfma_f32_16x16x32_bf16(af[ks], bw[ph * 4 + pb][ks], d, 0, 0, 0);
                            const float bbv = gld<float>(bs + (ph * 4 + pb) * 16 + fr);
                            u32x2 w; w[0] = cvtpk(bflo(uw[pb][0]) * (gn[0] * d[0] + bbv), bfhi(uw[pb][0]) * (gn[1] * d[1] + bbv));
                            w[1] = cvtpk(bflo(uw[pb][1]) * (gn[2] * d[2] + bbv), bfhi(uw[pb][1]) * (gn[3] * d[3] + bbv));
                            gst<u32x2>(ubase + (size_t)((ph * 4 + pb) * 16) * P_LD + cb * 16, w);
                        }
                        __builtin_amdgcn_sched_barrier(0);
                    }
                }
            }
            __syncthreads();
#endif
        } else if (op == OP_MEMATT) {
#ifndef NO_MEMATT
            static_assert(P_LD == C2_LD, "one row stride for both concat buffers"); bf16_t* buf = (l & 1) ? C2 : Pb; constexpr int ld = P_LD; const int qoff = (l & 1) ? 1024 : 1536;
            for (int it = 0; it < 8; ++it) {
                int t2 = tid; asm volatile("" : "+v"(t2)); const int wid = t2 >> 6;
                const int ai = it >> 2, h = it & 3; const int mb = ai ? 4 + (cu >> 7) : (cu >> 6);
                const bf16_t* kg = MEMKV + ((size_t)l * 1536 + mb * 256) * 1024 + h * 128;
                bf16_t* q = buf + (size_t)(ai * 128 + (wid & 3) * 32) * ld + qoff + h * 128;
                #if MLA_DMA
                attn_dma<false, P_LD, 1024, P_LD>(q, kg, kg + 512, 256, q, wid < 4, (char*)shm, t2);
#else
                attn_body<false, P_LD, 1024, P_LD>(q, kg, kg + 512, 256, q, wid < 4, (char*)shm, t2);
#endif
            }
#endif
        } else if (op == OP_KVPOST) {
            const float* kvg = PIN(21) + j * 128;
            const float g0 = gld<float>(kvg + lane * 2), g1 = gld<float>(kvg + lane * 2 + 1);
            for (int it = 0; it < 8; ++it) {
                float a0[4], a1[4], x1[4], x2[4], cc[4], sn[4];
#pragma unroll
                for (int u = 0; u < 4; ++u) { const int rr = wid + 8 * (4 * it + u), ai = rr >> 7, pr = rr & 127; const float* src = kvraw + (size_t)rr * (C2_LD / 2);
                    const int pos = (cu * 128 + pr) & (ai ? 16383 : 8191), l32 = lane & 31;
                    a0[u] = gld<float>(src + lane * 2); a1[u] = gld<float>(src + lane * 2 + 1);
                    x1[u] = gld<float>(src + 128 + l32); x2[u] = gld<float>(src + 160 + l32); cc[u] = gld<float>(rcos + pos * 32 + l32); sn[u] = gld<float>(rsin + pos * 32 + l32); }
#pragma unroll
                for (int u = 0; u < 4; ++u) { const int rr = wid + 8 * (4 * it + u), ai = rr >> 7, pr = rr & 127; const size_t g = (size_t)ai * TPROMPT + (size_t)cu * 128 + pr;
                    const float ss = wave_sum(a0[u] * a0[u] + a1[u] * a1[u]); const float rs = rsqrtf(ss * (1.f / 128.f) + EPS);
                    bf16_t* kd = KB + g * K_LD;
                    gst<unsigned>(kd + lane * 2, cvtpk(a0[u] * rs * g0, a1[u] * rs * g1));
                    if (lane < 32) { gst<bf16_t>(kd + 128 + lane, f2bf(x1[u] * cc[u] - x2[u] * sn[u])); gst<bf16_t>(kd + 160 + lane, f2bf(x1[u] * sn[u] + x2[u] * cc[u])); }
                }
            }
            __syncthreads();
        } else if (op == OP_MLA_ATT) {
#ifndef NO_MLAATT
            for (int it = 0; it < 8; ++it) {
                int t2 = tid; asm volatile("" : "+v"(t2)); const int wid = t2 >> 6;
                const int ai = it >> 2, hp = it & 3; const int seq = ai ? 16384 : 8192;
                const size_t g0 = (size_t)ai * TPROMPT + (size_t)cu * 128;
                const size_t s0 = (size_t)ai * TPROMPT + ((size_t)cu * 128 / seq) * seq;
                const int head = 2 * hp + (wid >> 2);
                const size_t lrow0 = (size_t)(ai * 128 + (wid & 3) * 32);
                #if MLA_DMA
                attn_dma<true, QF_LD, K_LD, C2_LD>(QF + lrow0 * QF_LD + head * 192, KB + s0 * K_LD, nullptr, seq, C2 + lrow0 * C2_LD + head * 128, true, (char*)shm, t2);
#else
                attn_body<true, QF_LD, K_LD, C2_LD>(QF + lrow0 * QF_LD + head * 192, KB + s0 * K_LD, nullptr, seq, C2 + lrow0 * C2_LD + head * 128, true, (char*)shm, t2);
#endif
            }
#endif
        } else {
            const float* fg = PIN(25);
            f32x4 gq[4];
#pragma unroll
            for (int q = 0; q < 4; ++q) gq[q] = gld<f32x4>(fg + q * 256 + lane * 4);
            for (int it = 0; it < 8; ++it) {
                u32x2 h[4][4], lo[4][4];
#pragma unroll
                for (int u = 0; u < 4; ++u) { const int rr = wid + 8 * (4 * it + u), ai = rr >> 7, pr = rr & 127; const bf16_t* row = X + ((size_t)ai * TPROMPT + (size_t)cu * 128 + pr) * XLD;
#pragma unroll
                    for (int q = 0; q < 4; ++q) { h[u][q] = gld<u32x2>(row + q * 256 + lane * 4); lo[u][q] = (u32x2){0u, 0u}; if (XLO) lo[u][q] = gld<u32x2>(row + 1024 + q * 256 + lane * 4); } }
                asm volatile("s_waitcnt vmcnt(0)" ::: "memory");
#pragma unroll
                for (int u = 0; u < 4; ++u) { const int rr = wid + 8 * (4 * it + u), ai = rr >> 7, pr = rr & 127; float* orow = (float*)(X + ((size_t)ai * TPROMPT + (size_t)cu * 128 + pr) * XLD); const float rs = st_rsx[rr];
#pragma unroll
                    for (int q = 0; q < 4; ++q) {
                        f32x4 y; y[0] = (bflo(h[u][q][0]) + bflo(lo[u][q][0])) * rs * gq[q][0]; y[1] = (bfhi(h[u][q][0]) + bfhi(lo[u][q][0])) * rs * gq[q][1];
                        y[2] = (bflo(h[u][q][1]) + bflo(lo[u][q][1])) * rs * gq[q][2]; y[3] = (bfhi(h[u][q][1]) + bfhi(lo[u][q][1])) * rs * gq[q][3];
                        gst<f32x4>(orow + q * 256 + lane * 4, y);
                    }
                }
            }
        }
    }
}

extern "C" void kernel_launch(void* const* d_in, const int* in_sizes, int n_in, void* d_out, int out_size, void* d_ws, size_t ws_size, hipStream_t stream) {
    static int ready = 0;
    if (ready == 0) {
        if (n_in != 26 || out_size != NTOK * DM || ws_size < WS_END) { fprintf(stderr, "kernel_launch: unexpected shapes (n_in %d out %d ws %zu need %zu)\n", n_in, out_size, ws_size, (size_t)WS_END); ready = -1; return; }
        if (hipFuncSetAttribute((const void*)fwd_megakernel, hipFuncAttributeMaxDynamicSharedMemorySize, LDS_TOTAL) != hipSuccess) { fprintf(stderr, "kernel_launch: hipFuncSetAttribute failed\n"); ready = -1; return; }
        int per_cu = 0; (void)hipOccupancyMaxActiveBlocksPerMultiprocessor(&per_cu, (const void*)fwd_megakernel, NTHR, LDS_TOTAL); (void)hipGetLastError();
        ready = 1;
    }
    if (ready < 0) return;
    Params p{};
    for (int i = 0; i < 26; ++i) p.in[i] = (const float*)d_in[i];
    p.out = (float*)d_out; p.ws = (unsigned char*)d_ws;
    if (hipMemsetAsync((unsigned char*)d_ws + WS_BAR, 0, 256, stream) != hipSuccess) { fprintf(stderr, "kernel_launch: memset of the barrier word failed\n"); return; }
    void* args[] = {&p};
    hipError_t e = hipLaunchCooperativeKernel((const void*)fwd_megakernel, dim3(NCU), dim3(NTHR), args, LDS_TOTAL, stream);
    if (e != hipSuccess) fprintf(stderr, "kernel_launch: cooperative launch failed: %s\n", hipGetErrorString(e));
}
```

```cpp
#include <hip/hip_runtime.h>
#include <hip/hip_cooperative_groups.h>
#include <cstdio>
#include <cstdint>
namespace cg = cooperative_groups;

#define LAS __attribute__((address_space(3)))
typedef unsigned short bf16_t;
typedef short bf16x8 __attribute__((ext_vector_type(8)));
typedef short s16x4 __attribute__((ext_vector_type(4)));
typedef float f32x4 __attribute__((ext_vector_type(4)));
typedef float f32x16 __attribute__((ext_vector_type(16)));
typedef unsigned u32x2 __attribute__((ext_vector_type(2)));
typedef unsigned u32x4 __attribute__((ext_vector_type(4)));

constexpr int NTOK = 65536, TPROMPT = 32768, DM = 1024, DFF = 2816;
constexpr int NCU = 256, NTHR = 512;
constexpr float EPS = 1e-6f;
#ifndef XLO
#define XLO 0
#endif
constexpr int XLD = 2048;
constexpr int HID_LD = 2816, P_LD = 2048, C2_LD = 2048, QF_LD = 1536, K_LD = 192;
constexpr int LDS_STAGE = 131072, LDS_TOTAL = 163840, LDS_ST = 131072, LDS_TAB = 159488;

constexpr size_t SZ_FFN_IN = (size_t)5632 * 1024 * 2, SZ_FFN_OUT = (size_t)1024 * 2816 * 2;
constexpr size_t SL_F1I = 0, SL_F1O = SL_F1I + SZ_FFN_IN, SL_F2I = SL_F1O + SZ_FFN_OUT, SL_F2O = SL_F2I + SZ_FFN_IN, SL_MIX = SL_F2O + SZ_FFN_OUT;
constexpr size_t SG_IN = SL_MIX, SG_OUT = SG_IN + (size_t)3584 * 1024 * 2, SG_WS = SG_OUT + (size_t)1024 * 2048 * 2, SLOTA_SZ = SG_WS + (size_t)8 * 128 * 128 * 2;
constexpr size_t ML_IN = SL_MIX, ML_Q = ML_IN + (size_t)1024 * 1024 * 2, ML_OUT = ML_Q + (size_t)1536 * 256 * 2, SLOTB_SZ = ML_OUT + (size_t)1024 * 1536 * 2;
constexpr size_t WS_SLOTA = 0, WS_SLOTB = WS_SLOTA + SLOTA_SZ;
constexpr size_t WS_MEMW = WS_SLOTB + SLOTB_SZ;
constexpr size_t WS_MEMN = WS_MEMW + (size_t)4 * 1024 * 1024 * 2;
constexpr size_t WS_MEMKV = WS_MEMN + (size_t)1536 * 1024 * 2;
constexpr size_t WS_ROPE = WS_MEMKV + (size_t)4 * 1536 * 1024 * 2;
constexpr size_t WS_KBUF = WS_ROPE + (size_t)2 * 16384 * 32 * 4;
constexpr size_t WS_SCR = WS_KBUF + (size_t)NTOK * K_LD * 2;
constexpr size_t SLAB = (size_t)256 * P_LD * 2 + (size_t)2 * 1536 * 128 * 2;
constexpr size_t SCR_HID = 0;
constexpr size_t SCR_P = 0, SCR_VT = (size_t)256 * P_LD * 2;
constexpr size_t SCR_QF = 0, SCR_C2 = (size_t)256 * QF_LD * 2;
static_assert(SCR_C2 + (size_t)256 * C2_LD * 2 <= SLAB && (size_t)256 * HID_LD * 2 <= SLAB, "slab too small");
constexpr size_t SCR_SZ = SLAB * NCU;
constexpr size_t WS_BAR = WS_SCR + SCR_SZ;
constexpr size_t WS_END = WS_BAR + 256;

struct Params { const float* in[26]; float* out; unsigned char* ws; };

#define GAS __attribute__((address_space(1)))
template <class T> __device__ __forceinline__ T gld(const void* p) { return *(const GAS T*)p; }
template <class T> __device__ __forceinline__ void gst(void* p, T v) { *(GAS T*)p = v; }
template <class T> __device__ __forceinline__ T* as_global(T* p) { return (T*)(__attribute__((address_space(1))) T*)p; }
__device__ __forceinline__ unsigned cvtpk(float lo, float hi) { unsigned r; asm volatile("v_cvt_pk_bf16_f32 %0, %1, %2" : "=v"(r) : "v"(lo), "v"(hi)); return r; }
__device__ __forceinline__ float bflo(unsigned w) { return __uint_as_float(w << 16); }
__device__ __forceinline__ float bfhi(unsigned w) { return __uint_as_float(w & 0xffff0000u); }
__device__ __forceinline__ bf16_t f2bf(float f) { return (bf16_t)(cvtpk(f, f) & 0xffffu); }
__device__ __forceinline__ float silu_f(float g) { return g * __builtin_amdgcn_rcpf(1.f + __expf(-g)); }
__device__ __forceinline__ float gelu_f(float x) { const float z = 1.5957691216057308f * (x + 0.044715f * x * x * x); return x * __builtin_amdgcn_rcpf(1.f + __expf(-z)); }
__device__ __forceinline__ f32x4 gelu4(f32x4 a, float r) {
    const f32x4 v = a * r, q = v * v; f32x4 e = v * (q * -0.10294324f + -2.30220819f);
    e[0] = __builtin_amdgcn_exp2f(e[0]); e[1] = __builtin_amdgcn_exp2f(e[1]); e[2] = __builtin_amdgcn_exp2f(e[2]); e[3] = __builtin_amdgcn_exp2f(e[3]);
    f32x4 d = e + 1.0f;
    d[0] = __builtin_amdgcn_rcpf(d[0]); d[1] = __builtin_amdgcn_rcpf(d[1]); d[2] = __builtin_amdgcn_rcpf(d[2]); d[3] = __builtin_amdgcn_rcpf(d[3]);
    return v * d;
}
__device__ __forceinline__ float wave_sum(float v) {
#pragma unroll
    for (int o = 32; o > 0; o >>= 1) v += __shfl_xor(v, o, 64);
    return v;
}

constexpr int BK = 64, HALF = 128, HTB = HALF * BK * 2;
#ifndef SNAKE
#define SNAKE 1
#endif
__device__ __forceinline__ int lds_byte(int r, int c) { const int st = (r >> 4) * 2 + (c >> 5), rr = r & 15, cc = c & 31, ob = rr * 64 + cc * 2; return st * 1024 + (ob ^ (((ob >> 9) & 1) << 5)); }
__device__ __forceinline__ void stage_rc(int b, int& R, int& C) { const int st = b / 1024, sb = b % 1024, swz = sb ^ (((sb >> 9) & 1) << 5); R = (st >> 1) * 16 + swz / 64; C = (st & 1) * 32 + (swz % 64) / 2; }

struct GemmArgs { const bf16_t* A; size_t hstepA; int lda; const bf16_t* Bt; int K; int nN; };
typedef f32x4 Acc[2][2][4][2];

enum { EP_FFN1 = 0, EP_XUPD, EP_SGU_IN, EP_MLA_IN, EP_MLA_Q, EP_MEMKV };
struct Epi {
    int mode; int cu; float alpha; unsigned char* ws; float* out; float* st;

    __device__ __forceinline__ size_t grow(int ai, int rr) const { return (size_t)ai * TPROMPT + (size_t)cu * 128 + rr; }
    __device__ __forceinline__ size_t lrow(int ai, int rr) const { return (size_t)(ai * 128 + rr); }

    __device__ __forceinline__ void operator()(Acc& acc, int pn, int wr, int wc, int fr, int fq) const {
        asm volatile("" : "+v"(fr), "+v"(fq));
        unsigned char* const slab = ws + WS_SCR + (size_t)cu * SLAB;
        float* const st_rsx_ = st, *const st_rq_ = st + 512, *const st_xacc_ = st + 1024 + wc * 256, *const st_vacc_ = st + 2048 + wc * 256, *const st_qacc_ = st + 3072 + wc * 256;
        if (mode == EP_FFN1) {
            bf16_t* const o0 = (bf16_t*)(slab + SCR_HID); constexpr int ld0 = HID_LD; const float* const st_r = st_rsx_;
#pragma unroll
            for (int ai = 0; ai < 2; ++ai)
#pragma unroll
                for (int m = 0; m < 4; ++m) {
                    const int rr = wr * 64 + m * 16 + fr; const float r = st_r[ai * 128 + rr];
                    bf16_t* rowp = o0 + lrow(ai, rr) * (size_t)ld0 + pn * 128 + wc * 32 + fq * 8;
                    u32x4 w; const float c1 = -1.4426950408889634f * r, r2 = r * r;
#pragma unroll
                    for (int n = 0; n < 2; ++n) {
                        const f32x4 g = acc[ai][0][m][n], u = acc[ai][1][m][n];
                        f32x4 e = g * c1;
                        e[0] = __builtin_amdgcn_exp2f(e[0]); e[1] = __builtin_amdgcn_exp2f(e[1]); e[2] = __builtin_amdgcn_exp2f(e[2]); e[3] = __builtin_amdgcn_exp2f(e[3]);
                        f32x4 d = e + 1.0f;
                        d[0] = __builtin_amdgcn_rcpf(d[0]); d[1] = __builtin_amdgcn_rcpf(d[1]); d[2] = __builtin_amdgcn_rcpf(d[2]); d[3] = __builtin_amdgcn_rcpf(d[3]);
                        const f32x4 h = (g * u) * (d * r2);
                        w[2 * n] = cvtpk(h[0], h[1]); w[2 * n + 1] = cvtpk(h[2], h[3]);
                    }
                    gst<u32x4>(rowp, w);
                }
        } else if (mode == EP_XUPD) {
            bf16_t* const x = (bf16_t*)out; float* const st_acc = st_xacc_;
#pragma unroll
            for (int ai = 0; ai < 2; ++ai)
#pragma unroll
                for (int m = 0; m < 4; ++m) {
                    const int rr = wr * 64 + m * 16 + fr;
                    bf16_t* rowp = x + grow(ai, rr) * (size_t)XLD + pn * 256 + wc * 32 + fq * 8;
                    float ss = 0.f;
#pragma unroll
                    for (int bj = 0; bj < 2; ++bj) {
                        bf16_t* p = rowp + bj * 128;
                        const u32x4 h = gld<u32x4>(p); u32x4 l = {0u, 0u, 0u, 0u}; if (XLO) l = gld<u32x4>(p + 1024);
                        u32x4 nh, nl;
#pragma unroll
                        for (int n = 0; n < 2; ++n) {
                            const f32x4 a = acc[ai][bj][m][n];
                            const float x0 = bflo(h[2 * n]) + bflo(l[2 * n]) + alpha * a[0], x1 = bfhi(h[2 * n]) + bfhi(l[2 * n]) + alpha * a[1];
                            const float x2 = bflo(h[2 * n + 1]) + bflo(l[2 * n + 1]) + alpha * a[2], x3 = bfhi(h[2 * n + 1]) + bfhi(l[2 * n + 1]) + alpha * a[3];
                            ss += x0 * x0 + x1 * x1 + x2 * x2 + x3 * x3;
                            nh[2 * n] = cvtpk(x0, x1); nh[2 * n + 1] = cvtpk(x2, x3);
                            if (XLO) { nl[2 * n] = cvtpk(x0 - bflo(nh[2 * n]), x1 - bfhi(nh[2 * n])); nl[2 * n + 1] = cvtpk(x2 - bflo(nh[2 * n + 1]), x3 - bfhi(nh[2 * n + 1])); }
                        }
                        gst<u32x4>(p, nh); if (XLO) gst<u32x4>(p + 1024, nl);
                    }
                    ss += __shfl_xor(ss, 16, 64); ss += __shfl_xor(ss, 32, 64);
                    if (fq == 0) st_acc[ai * 128 + rr] += ss;
                }
        } else if (mode == EP_SGU_IN) {
            bf16_t* const o0 = (bf16_t*)(slab + SCR_P); constexpr int ld0 = P_LD; const float* const st_r = st_rsx_; float* const st_acc = st_vacc_;
            bf16_t* const vt = (bf16_t*)(slab + SCR_VT);
            if (pn < 8) {
#pragma unroll
                for (int ai = 0; ai < 2; ++ai)
#pragma unroll
                    for (int m = 0; m < 4; ++m) {
                        const int rr = wr * 64 + m * 16 + fr; const float r = st_r[ai * 128 + rr];
                        bf16_t* rowp = o0 + lrow(ai, rr) * (size_t)ld0 + pn * 256 + wc * 32 + fq * 8;
#pragma unroll
                        for (int bj = 0; bj < 2; ++bj) {
                            u32x4 w;
#pragma unroll
                            for (int n = 0; n < 2; ++n) {
                                const f32x4 v = (pn < 6) ? gelu4(acc[ai][bj][m][n], r) : acc[ai][bj][m][n] * r;
                                w[2 * n] = cvtpk(v[0], v[1]); w[2 * n + 1] = cvtpk(v[2], v[3]);
                            }
                            gst<u32x4>(rowp + bj * 128, w);
                        }
                    }
            } else {
#pragma unroll
                for (int ai = 0; ai < 2; ++ai)
#pragma unroll
                    for (int m = 0; m < 4; ++m) {
                        const int rr = wr * 64 + m * 16 + fr; const float r = st_r[ai * 128 + rr];
                        bf16_t* colp = vt + ((size_t)ai * 1536 + (size_t)(pn - 8) * 256 + wc * 32 + fq * 8) * 128 + rr;
                        float ss = 0.f;
#pragma unroll
                        for (int bj = 0; bj < 2; ++bj)
#pragma unroll
                            for (int n = 0; n < 2; ++n) {
                                const f32x4 gv = gelu4(acc[ai][bj][m][n], r);
#pragma unroll
                                for (int i = 0; i < 4; ++i) { const float v = gv[i]; ss += v * v; gst<bf16_t>(colp + (size_t)(bj * 128 + n * 4 + i) * 128, f2bf(v)); }
                            }
                        ss += __shfl_xor(ss, 16, 64); ss += __shfl_xor(ss, 32, 64);
                        if (fq == 0) st_acc[ai * 128 + rr] += ss;
                    }
            }
        } else if (mode == EP_MLA_IN) {
            bf16_t* const c2 = (bf16_t*)(slab + SCR_C2); bf16_t* const o0 = c2; constexpr int ld0 = C2_LD, ldkv = C2_LD / 2; float* const kvraw = (float*)(c2 + 256);
            const float* const st_r = st_rsx_; float* const st_acc = st_qacc_;
            if (pn == 0) {
#pragma unroll
                for (int ai = 0; ai < 2; ++ai)
#pragma unroll
                    for (int m = 0; m < 4; ++m) {
                        const int rr = wr * 64 + m * 16 + fr; const float r = st_r[ai * 128 + rr];
                        bf16_t* rowp = o0 + lrow(ai, rr) * (size_t)ld0 + wc * 32 + fq * 8;
                        float ss = 0.f;
#pragma unroll
                        for (int bj = 0; bj < 2; ++bj)
#pragma unroll
                            for (int n = 0; n < 2; ++n) {
                                const f32x4 v = acc[ai][bj][m][n] * r;
                                ss += v[0] * v[0] + v[1] * v[1] + v[2] * v[2] + v[3] * v[3];
                                u32x2 w; w[0] = cvtpk(v[0], v[1]); w[1] = cvtpk(v[2], v[3]);
                                gst<u32x2>(rowp + bj * 128 + n * 4, w);
                            }
                        ss += __shfl_xor(ss, 16, 64); ss += __shfl_xor(ss, 32, 64);
                        if (fq == 0) st_acc[ai * 128 + rr] += ss;
                        __builtin_amdgcn_sched_barrier(0);
                    }
            } else if (pn == 1) {
#pragma unroll
                for (int ai = 0; ai < 2; ++ai)
#pragma unroll
                    for (int m = 0; m < 4; ++m) {
                        const int rr = wr * 64 + m * 16 + fr; const float r = st_r[ai * 128 + rr];
                        float* rowp = kvraw + lrow(ai, rr) * (size_t)ldkv + wc * 32 + fq * 8;
#pragma unroll
                        for (int n = 0; n < 2; ++n) {
                            gst<f32x4>(rowp + n * 4, acc[ai][0][m][n] * r);
                            if (wc < 2) gst<f32x4>(rowp + 128 + n * 4, acc[ai][1][m][n] * r);
                        }
                        __builtin_amdgcn_sched_barrier(0);
                    }
            } else {
#pragma unroll
                for (int ai = 0; ai < 2; ++ai)
#pragma unroll
                    for (int m = 0; m < 4; ++m) {
                        const int rr = wr * 64 + m * 16 + fr; const float r = st_r[ai * 128 + rr];
                        bf16_t* rowp = c2 + lrow(ai, rr) * (size_t)C2_LD + 1024 + (pn - 2) * 256 + wc * 32 + fq * 8;
#pragma unroll
                        for (int bj = 0; bj < 2; ++bj)
#pragma unroll
                            for (int n = 0; n < 2; ++n) {
                                const f32x4 v = acc[ai][bj][m][n] * r;
                                u32x2 w; w[0] = cvtpk(v[0], v[1]); w[1] = cvtpk(v[2], v[3]);
                                gst<u32x2>(rowp + bj * 128 + n * 4, w);
                            }
                        __builtin_amdgcn_sched_barrier(0);
                    }
            }
        } else if (mode == EP_MLA_Q) {
            bf16_t* const o0 = (bf16_t*)(slab + SCR_QF); constexpr int ld0 = QF_LD; const float* const st_r = st_rq_;
            const float* const rcos = (const float*)(ws + WS_ROPE); const float* const rsin = rcos + 16384 * 32;
            if (pn < 4) {
#pragma unroll
                for (int ai = 0; ai < 2; ++ai)
#pragma unroll
                    for (int m = 0; m < 4; ++m) {
                        const int rr = wr * 64 + m * 16 + fr; const float r = st_r[ai * 128 + rr];
                        bf16_t* rowp = o0 + lrow(ai, rr) * (size_t)ld0 + 2 * pn * 192 + wc * 32 + fq * 8;
#pragma unroll
                        for (int bj = 0; bj < 2; ++bj)
#pragma unroll
                            for (int n = 0; n < 2; ++n) {
                                const f32x4 v = acc[ai][bj][m][n] * r;
                                u32x2 w; w[0] = cvtpk(v[0], v[1]); w[1] = cvtpk(v[2], v[3]);
                                gst<u32x2>(rowp + bj * 192 + n * 4, w);
                            }
                        __builtin_amdgcn_sched_barrier(0);
                    }
            } else {
#pragma unroll
                for (int ai = 0; ai < 2; ++ai)
#pragma unroll
                    for (int m = 0; m < 4; ++m) {
                        const int rr = wr * 64 + m * 16 + fr; const float r = st_r[ai * 128 + rr];
                        const int pos = (cu * 128 + rr) & (ai ? 16383 : 8191);
                        bf16_t* rowp = o0 + lrow(ai, rr) * (size_t)ld0 + (4 * (pn - 4) + wc) * 192 + 128 + fq * 8;
                        const float* cp = rcos + pos * 32 + fq * 8; const float* sp = rsin + pos * 32 + fq * 8;
#pragma unroll
                        for (int n = 0; n < 2; ++n) {
                            const f32x4 c = gld<f32x4>(cp + n * 4), s = gld<f32x4>(sp + n * 4);
                            const f32x4 x1 = acc[ai][0][m][n] * r, x2 = acc[ai][1][m][n] * r;
                            const f32x4 y1 = x1 * c - x2 * s, y2 = x1 * s + x2 * c;
                            u32x2 w1, w2; w1[0] = cvtpk(y1[0], y1[1]); w1[1] = cvtpk(y1[2], y1[3]); w2[0] = cvtpk(y2[0], y2[1]); w2[1] = cvtpk(y2[2], y2[3]);
                            gst<u32x2>(rowp + n * 4, w1); gst<u32x2>(rowp + 32 + n * 4, w2);
                        }
                        __builtin_amdgcn_sched_barrier(0);
                    }
            }
        } else {
            const int pn0 = cu & 3; constexpr int ld0 = 1024;
            bf16_t* const o0 = (bf16_t*)(ws + WS_MEMKV) + ((size_t)(cu / 24) * 1536 + ((cu % 24) >> 2) * 256) * 1024;
#pragma unroll
            for (int ai = 0; ai < 2; ++ai)
#pragma unroll
                for (int m = 0; m < 4; ++m) {
                    bf16_t* rowp = o0 + (size_t)(ai * 128 + wr * 64 + m * 16 + fr) * ld0 + pn0 * 256 + wc * 32 + fq * 8;
#pragma unroll
                    for (int bj = 0; bj < 2; ++bj)
#pragma unroll
                        for (int n = 0; n < 2; ++n) {
                            const f32x4 v = acc[ai][bj][m][n];
                            u32x2 w; w[0] = cvtpk(v[0], v[1]); w[1] = cvtpk(v[2], v[3]);
                            gst<u32x2>(rowp + bj * 128 + n * 4, w);
                        }
                }
        }
    }
};

__device__ __forceinline__ void gemm_phase(LAS unsigned char* lds, const GemmArgs g, const Epi& E, const int tid) {
    const int wid = __builtin_amdgcn_readfirstlane(tid >> 6), lane = tid & 63, wr = wid >> 2, wc = wid & 3, fr = lane & 15, fq = lane >> 4;
    const int K = g.K, nt = K / BK;
    unsigned voffA[2], voffB[2];
#pragma unroll
    for (int i = 0; i < 2; ++i) { int R, C; stage_rc(tid * 16 + i * 8192, R, C); const int rho = R & 31, Rb = (R & ~31) + 8 * ((rho & 15) >> 2) + 4 * (rho >> 4) + (rho & 3);
        voffA[i] = (unsigned)(R * g.lda + C) * 2u; voffB[i] = (unsigned)(Rb * K + C) * 2u; }
    const size_t kstep = (size_t)(BK * 2);
    const size_t hstepB = (size_t)HALF * K * 2, tstepB = 2 * hstepB, hstepA = g.hstepA;
    const unsigned ldsw = (unsigned)wid * 1024u;
    const int aoff = lds_byte(wr * 64 + fr, fq * 8), boff = lds_byte(wc * 32 + fr, fq * 8);
#define PG8_SA(b, h) (((b) * 2 + (h)) * HTB)
#define PG8_SB(b, h) ((4 + (b) * 2 + (h)) * HTB)
#define PG8_STAGE(bufoff, gbase, voff) do { _Pragma("unroll") for (int _i = 0; _i < 2; ++_i) \
        __builtin_amdgcn_global_load_lds((const unsigned*)((const char*)(gbase) + (voff)[_i]), (LAS unsigned*)(lds + (bufoff) + ldsw + _i * 8192), 16, 0, 0); } while (0)
#define PG8_LDA(dst, b, h) do { _Pragma("unroll") for (int m = 0; m < 4; ++m) _Pragma("unroll") for (int k = 0; k < 2; ++k) dst[m][k] = *(const LAS bf16x8*)(lds + PG8_SA(b, h) + aoff + m * 2048 + k * 1024); } while (0)
#define PG8_LDB(dst, b, h) do { _Pragma("unroll") for (int n = 0; n < 2; ++n) _Pragma("unroll") for (int k = 0; k < 2; ++k) dst[n][k] = *(const LAS bf16x8*)(lds + PG8_SB(b, h) + boff + n * 2048 + k * 1024); } while (0)
#define PG8_MMA(ai, bj, At, Bt) do { __builtin_amdgcn_s_setprio(1); _Pragma("unroll") for (int m = 0; m < 4; ++m) _Pragma("unroll") for (int n = 0; n < 2; ++n) _Pragma("unroll") for (int k = 0; k < 2; ++k) \
        acc[ai][bj][m][n] = __builtin_amdgcn_mfma_f32_16x16x32_bf16(Bt[n][k], At[m][k], acc[ai][bj][m][n], 0, 0, 0); __builtin_amdgcn_s_setprio(0); } while (0)
#define PG8_WAIT_V(n) asm volatile("s_waitcnt vmcnt(" #n ")" ::: "memory")
#define PG8_WAIT_L(n) asm volatile("s_waitcnt lgkmcnt(" #n ")" ::: "memory")
#define PG8_BAR __builtin_amdgcn_s_barrier()
#define PG8_SCHED __builtin_amdgcn_sched_barrier(0)
    int ui = 0;
    Acc acc;
#pragma unroll
    for (int a = 0; a < 2; ++a)
#pragma unroll
        for (int b = 0; b < 2; ++b)
#pragma unroll
            for (int m = 0; m < 4; ++m)
#pragma unroll
                for (int n = 0; n < 2; ++n) acc[a][b][m][n] = (f32x4){0.f, 0.f, 0.f, 0.f};
    bf16x8 At[4][2], B0[2][2], B1[2][2];
    const ptrdiff_t KS = (ptrdiff_t)(BK * 2), lastoff = (ptrdiff_t)(nt - 1) * KS;
    const char* cA = (const char*)g.A; const char* cB = (const char*)g.Bt; ptrdiff_t ks = KS;
    PG8_STAGE(PG8_SB(0, 0), cB, voffB); PG8_STAGE(PG8_SA(0, 0), cA, voffA); PG8_STAGE(PG8_SB(0, 1), cB + hstepB, voffB); PG8_STAGE(PG8_SA(0, 1), cA + hstepA, voffA);
    if (wr == 1) PG8_BAR;
    PG8_WAIT_V(4); PG8_BAR;
    PG8_STAGE(PG8_SB(1, 0), cB + kstep, voffB); PG8_STAGE(PG8_SA(1, 0), cA + kstep, voffA); PG8_STAGE(PG8_SB(1, 1), cB + hstepB + kstep, voffB);
    PG8_WAIT_V(6); PG8_BAR;
    for (;;) {
        const bool has_next = (ui + 1 < g.nN);
        const bool nrev = SNAKE && (((ui + 1) & 1) != 0);
        const char* nA = has_next ? (const char*)g.A + (nrev ? lastoff : 0) : cA;
        const char* nB = has_next ? (const char*)g.Bt + (size_t)(ui + 1) * tstepB + (nrev ? lastoff : 0) : cB;
        const ptrdiff_t nks = has_next ? (nrev ? -KS : KS) : ks;
        for (int t = 0; t < nt; t += 2) {
            const bool last = (t == nt - 2);
            const char* a1 = cA + (ptrdiff_t)(t + 1) * ks;
            const char* a2 = last ? nA : cA + (ptrdiff_t)(t + 2) * ks; const char* b2 = last ? nB : cB + (ptrdiff_t)(t + 2) * ks;
            const ptrdiff_t k3 = last ? nks : ks;
            const char* a3 = a2 + k3; const char* b3 = b2 + k3;
            PG8_LDB(B0, 0, 0); PG8_SCHED; PG8_LDA(At, 0, 0); PG8_STAGE(PG8_SA(1, 1), a1 + hstepA, voffA);
            PG8_WAIT_L(8); PG8_BAR; PG8_WAIT_L(0); PG8_MMA(0, 0, At, B0); PG8_BAR; PG8_SCHED;
            PG8_LDB(B1, 0, 1); PG8_STAGE(PG8_SB(0, 0), b2, voffB);
            PG8_BAR; PG8_WAIT_L(0); PG8_MMA(0, 1, At, B1); PG8_BAR;
            PG8_LDA(At, 0, 1); PG8_STAGE(PG8_SA(0, 0), a2, voffA);
            PG8_BAR; PG8_WAIT_L(0); PG8_MMA(1, 0, At, B0); PG8_BAR; PG8_SCHED;
            PG8_STAGE(PG8_SB(0, 1), b2 + hstepB, voffB);
            PG8_WAIT_V(6); PG8_BAR; PG8_MMA(1, 1, At, B1); PG8_BAR;
            PG8_LDB(B0, 1, 0); PG8_SCHED; PG8_LDA(At, 1, 0); PG8_STAGE(PG8_SA(0, 1), a2 + hstepA, voffA);
            PG8_WAIT_L(8); PG8_BAR; PG8_WAIT_L(0); PG8_MMA(0, 0, At, B0); PG8_BAR; PG8_SCHED;
            PG8_LDB(B1, 1, 1); PG8_STAGE(PG8_SB(1, 0), b3, voffB);
            PG8_BAR; PG8_WAIT_L(0); PG8_MMA(0, 1, At, B1); PG8_BAR;
            PG8_LDA(At, 1, 1); PG8_STAGE(PG8_SA(1, 0), a3, voffA);
            PG8_BAR; PG8_WAIT_L(0); PG8_MMA(1, 0, At, B0); PG8_BAR; PG8_SCHED;
            PG8_STAGE(PG8_SB(1, 1), b3 + hstepB, voffB);
            PG8_WAIT_V(6); PG8_BAR; PG8_MMA(1, 1, At, B1); PG8_BAR;
        }
        E(acc, ui, wr, wc, fr, fq);
        if (!has_next) break;
#pragma unroll
        for (int a = 0; a < 2; ++a)
#pragma unroll
            for (int b = 0; b < 2; ++b)
#pragma unroll
                for (int m = 0; m < 4; ++m)
#pragma unroll
                    for (int n = 0; n < 2; ++n) acc[a][b][m][n] = (f32x4){0.f, 0.f, 0.f, 0.f};
        cA = nA; cB = nB; ks = nks; ++ui;
    }
    PG8_WAIT_V(0);
    if (wr == 0) PG8_BAR;
    PG8_BAR;
#undef PG8_SA
#undef PG8_SB
#undef PG8_STAGE
#undef PG8_LDA
#undef PG8_LDB
#undef PG8_MMA
#undef PG8_WAIT_V
#undef PG8_WAIT_L
#undef PG8_BAR
#undef PG8_SCHED
    __syncthreads();
}

#define KSWZ(row, colB) ((row) * 256 + ((colB) ^ (((row) & 15) << 4)))
#define KRSWZ(row, colB) ((row) * 128 + ((colB) ^ ((((row) >> 1) & 7) << 4)))
#define SBAR() __builtin_amdgcn_sched_barrier(0)
constexpr float ATT_THR = 8.f;
constexpr int SHM_V = 64 * 128 * 2, SHM_K = 64 * 128 * 2, SHM_KR = 64 * 64 * 2;
constexpr int AL_V = 0, AL_K = 2 * SHM_V, AL_KR = AL_K + 2 * SHM_K, AL_WS = AL_KR + 2 * SHM_KR, AL_Q = AL_WS + 2048;
#ifndef MLA_DMA
#define MLA_DMA 1
#endif
#ifndef MLA_NQL
#define MLA_NQL 4
#endif
#ifndef MLA_SD
#define MLA_SD 1
#endif
constexpr int NQL = MLA_NQL;
static_assert(AL_Q + 8 * NQL * 1024 <= LDS_TAB, "attention LDS overflows into the statistics");
__device__ __forceinline__ int crow(int r, int hi) { return (r & 3) + 8 * (r >> 2) + 4 * hi; }

template <bool MLA> __device__ __forceinline__ void partialSM(f32x16& p0, f32x16& p1, float& m_reg, float& mn, float& alpha) {
    constexpr float SCALE = MLA ? 1.0f : 0.088388347648318440f;
    constexpr float C = SCALE * 1.4426950408889634f;
    float pmax = p0[0];
#pragma unroll
    for (int r = 1; r < 16; ++r) pmax = fmaxf(pmax, p0[r]);
#pragma unroll
    for (int r = 0; r < 16; ++r) pmax = fmaxf(pmax, p1[r]);
    { auto rr = __builtin_amdgcn_permlane32_swap(__float_as_uint(pmax), __float_as_uint(pmax), false, false);
      pmax = fmaxf(__uint_as_float(rr[0]), __uint_as_float(rr[1])); }
    if (__builtin_expect(__all(pmax - m_reg <= ATT_THR / SCALE), 1)) { mn = m_reg; alpha = 1.f; }
    else { mn = fmaxf(m_reg, pmax); alpha = __builtin_amdgcn_exp2f((m_reg - mn) * C); m_reg = mn; }
    const float mnC = -mn * C;
#pragma unroll
    for (int r = 0; r < 16; ++r) p0[r] = fmaf(p0[r], C, mnC);
#pragma unroll
    for (int r = 0; r < 16; ++r) p1[r] = fmaf(p1[r], C, mnC);
#pragma unroll
    for (int r = 0; r < 16; ++r) p0[r] = __builtin_amdgcn_exp2f(p0[r]);
}
__device__ __forceinline__ void finishSM(f32x16& p0, f32x16& p1, float alpha, float& l_reg, bf16x8& pa0, bf16x8& pa1, bf16x8& pa2, bf16x8& pa3) {
#pragma unroll
    for (int r = 0; r < 16; ++r) p1[r] = __builtin_amdgcn_exp2f(p1[r]);
    float ps = 0;
#pragma unroll
    for (int r = 0; r < 16; ++r) ps += p0[r];
#pragma unroll
    for (int r = 0; r < 16; ++r) ps += p1[r];
    { auto rr = __builtin_amdgcn_permlane32_swap(__float_as_uint(ps), __float_as_uint(ps), false, false);
      ps = __uint_as_float(rr[0]) + __uint_as_float(rr[1]); }
    l_reg = l_reg * alpha + ps;
#define PK4(P, BASE, OUT) do { unsigned a0 = cvtpk(P[BASE + 0], P[BASE + 1]), a1 = cvtpk(P[BASE + 2], P[BASE + 3]);   \
    unsigned b0 = cvtpk(P[BASE + 4], P[BASE + 5]), b1 = cvtpk(P[BASE + 6], P[BASE + 7]);                              \
    auto r0 = __builtin_amdgcn_permlane32_swap(a0, b0, false, false); auto r1 = __builtin_amdgcn_permlane32_swap(a1, b1, false, false); \
    u32x4 w = {r0[0], r1[0], r0[1], r1[1]}; OUT = *reinterpret_cast<bf16x8*>(&w); } while (0)
    PK4(p0, 0, pa0); PK4(p0, 8, pa1); PK4(p1, 0, pa2); PK4(p1, 8, pa3);
#undef PK4
}
template <bool MLA> __device__ __forceinline__ void qkt(f32x16& p0, f32x16& p1, const char* Ks, const char* KRs, const bf16x8* qr, const char* ql, int r32, int hi) {
    p0 = f32x16{}; p1 = f32x16{};
#pragma unroll
    for (int d0 = 0; d0 < 8; ++d0) { const int cb = (d0 * 16 + hi * 8) * 2;
        const bf16x8 b0 = *reinterpret_cast<const bf16x8*>(Ks + KSWZ(r32, cb));
        const bf16x8 b1 = *reinterpret_cast<const bf16x8*>(Ks + KSWZ(32 + r32, cb));
        const bf16x8 qq = (MLA && d0 >= 12 - NQL) ? *reinterpret_cast<const bf16x8*>(ql + (d0 - (12 - NQL)) * 1024) : qr[(MLA && d0 >= 12 - NQL) ? 0 : d0];
        p0 = __builtin_amdgcn_mfma_f32_32x32x16_bf16(b0, qq, p0, 0, 0, 0);
        p1 = __builtin_amdgcn_mfma_f32_32x32x16_bf16(b1, qq, p1, 0, 0, 0); }
    if constexpr (MLA) {
#pragma unroll
        for (int d0 = 0; d0 < 4; ++d0) { const int cb = (d0 * 16 + hi * 8) * 2;
            const bf16x8 b0 = *reinterpret_cast<const bf16x8*>(KRs + KRSWZ(r32, cb));
            const bf16x8 b1 = *reinterpret_cast<const bf16x8*>(KRs + KRSWZ(32 + r32, cb));
            const bf16x8 qq = (8 + d0 >= 12 - NQL) ? *reinterpret_cast<const bf16x8*>(ql + (8 + d0 - (12 - NQL)) * 1024) : qr[(8 + d0 >= 12 - NQL) ? 0 : 8 + d0];
            p0 = __builtin_amdgcn_mfma_f32_32x32x16_bf16(b0, qq, p0, 0, 0, 0);
            p1 = __builtin_amdgcn_mfma_f32_32x32x16_bf16(b1, qq, p1, 0, 0, 0); }
    }
}
__device__ __forceinline__ int v_st(int k, int c) { const int kk = (k & ~0xC) | ((k & 4) << 1) | ((k & 8) >> 1); return ((kk >> 3) * 4 + (c >> 5)) * 512 + ((kk & 7) * 32 + (c & 31)) * 2; }
__device__ __forceinline__ int v_rd_base(int lane) { return ((lane & 3) << 3) | (((lane >> 2) & 3) << 6) | (((lane >> 4) & 1) << 5) | (((lane >> 5) & 1) << 8); }
constexpr int v_rd_off(int d0, int ks, int half) { return d0 * 512 + ks * 4096 + half * 2048; }
template <int OFF> __device__ __forceinline__ s16x4 tr_read(int vb) {
    s16x4 r; asm volatile("ds_read_b64_tr_b16 %0, %1 offset:%2" : "=&v"(r) : "v"(vb), "i"(OFF) : "memory"); return r;
}
template <int D0> __device__ __forceinline__ void pv_one(f32x16& od, int vb, bf16x8 pa0, bf16x8 pa1, bf16x8 pa2, bf16x8 pa3) {
    const s16x4 l0 = tr_read<v_rd_off(D0, 0, 0)>(vb), h0 = tr_read<v_rd_off(D0, 0, 1)>(vb), l1 = tr_read<v_rd_off(D0, 1, 0)>(vb), h1 = tr_read<v_rd_off(D0, 1, 1)>(vb);
    const s16x4 l2 = tr_read<v_rd_off(D0, 2, 0)>(vb), h2 = tr_read<v_rd_off(D0, 2, 1)>(vb), l3 = tr_read<v_rd_off(D0, 3, 0)>(vb), h3 = tr_read<v_rd_off(D0, 3, 1)>(vb);
    asm volatile("s_waitcnt lgkmcnt(0)" ::: "memory"); SBAR();
#define PK(L, H) (bf16x8){L[0], L[1], L[2], L[3], H[0], H[1], H[2], H[3]}
    od = __builtin_amdgcn_mfma_f32_32x32x16_bf16(pa0, PK(l0, h0), od, 0, 0, 0);
    od = __builtin_amdgcn_mfma_f32_32x32x16_bf16(pa1, PK(l1, h1), od, 0, 0, 0);
    od = __builtin_amdgcn_mfma_f32_32x32x16_bf16(pa2, PK(l2, h2), od, 0, 0, 0);
    od = __builtin_amdgcn_mfma_f32_32x32x16_bf16(pa3, PK(l3, h3), od, 0, 0, 0);
#undef PK
}
__device__ __forceinline__ void pv_d0(f32x16* o, int vb, bf16x8 pa0, bf16x8 pa1, bf16x8 pa2, bf16x8 pa3) {
    pv_one<0>(o[0], vb, pa0, pa1, pa2, pa3); pv_one<1>(o[1], vb, pa0, pa1, pa2, pa3); pv_one<2>(o[2], vb, pa0, pa1, pa2, pa3); pv_one<3>(o[3], vb, pa0, pa1, pa2, pa3);
}

template <bool MLA, int ldq, int ldk, int ldo>
__device__ __forceinline__ void attn_body(const bf16_t* __restrict__ Qw, const bf16_t* __restrict__ Kg, const bf16_t* __restrict__ Vg, int seq,
                                          bf16_t* __restrict__ Ow, bool do_store, char* lds, const int tid) {
    constexpr int NQ = MLA ? 12 - NQL : 8;
    const int wid = tid >> 6, lane = tid & 63, r32 = lane & 31, hi = lane >> 5;
    char* V_lds = lds + AL_V; char* K_lds = lds + AL_K; char* KR_lds = lds + AL_KR;
    float* ws = (float*)(lds + AL_WS) + wid * 64; float* li_l = ws; float* al_l = ws + 32;
    float m_reg = -1e30f, l_reg = 0; f32x16 o[4] = {}; bf16x8 qr[NQ];
    const bf16_t* Ql = Qw + (size_t)r32 * ldq + hi * 8;
#pragma unroll
    for (int d0 = 0; d0 < NQ; ++d0) qr[d0] = gld<bf16x8>(Ql + d0 * 16);
    const char* ql = lds + AL_Q + wid * (NQL * 1024) + lane * 16;
    if constexpr (MLA) {
#pragma unroll
        for (int d0 = NQ; d0 < 12; ++d0) *(bf16x8*)(lds + AL_Q + wid * (NQL * 1024) + (d0 - NQ) * 1024 + lane * 16) = gld<bf16x8>(Ql + d0 * 16);
    }
    const int sr = tid >> 4, sc = (tid & 15) * 8, vst0 = v_st(sr, sc), vst1 = v_st(32 + sr, sc);
    const int rr_ = tid >> 3, rc_ = (tid & 7) * 8;
    const int vb0 = (int)(uintptr_t)V_lds + v_rd_base(lane);
    constexpr int SD = MLA ? MLA_SD : 2;
    struct { bf16x8 vs0, vs1, ks0, ks1; } sr_[SD];
#define SLOAD(i, k0) do { if constexpr (MLA) { \
        sr_[i].ks0 = gld<bf16x8>(&Kg[(size_t)((k0) + sr) * ldk + sc]); sr_[i].ks1 = gld<bf16x8>(&Kg[(size_t)((k0) + 32 + sr) * ldk + sc]); \
        sr_[i].vs0 = gld<bf16x8>(&Kg[(size_t)((k0) + rr_) * ldk + 128 + rc_]); \
    } else { \
        sr_[i].vs0 = gld<bf16x8>(&Vg[(size_t)((k0) + sr) * ldk + sc]); sr_[i].vs1 = gld<bf16x8>(&Vg[(size_t)((k0) + 32 + sr) * ldk + sc]); \
        sr_[i].ks0 = gld<bf16x8>(&Kg[(size_t)((k0) + sr) * ldk + sc]); sr_[i].ks1 = gld<bf16x8>(&Kg[(size_t)((k0) + 32 + sr) * ldk + sc]); } } while (0)
#define SWRITE(b, i) do { const int kc = sc * 2; if constexpr (MLA) { \
        *(bf16x8*)(V_lds + (b) * SHM_V + vst0) = sr_[i].ks0; *(bf16x8*)(V_lds + (b) * SHM_V + vst1) = sr_[i].ks1; \
        *(bf16x8*)(KR_lds + (b) * SHM_KR + KRSWZ(rr_, rc_ * 2)) = sr_[i].vs0; \
    } else { \
        *(bf16x8*)(V_lds + (b) * SHM_V + vst0) = sr_[i].vs0; *(bf16x8*)(V_lds + (b) * SHM_V + vst1) = sr_[i].vs1; } \
        *(bf16x8*)(K_lds + (b) * SHM_K + KSWZ(sr, kc)) = sr_[i].ks0; *(bf16x8*)(K_lds + (b) * SHM_K + KSWZ(32 + sr, kc)) = sr_[i].ks1; } while (0)
#define SWAIT() do { if constexpr (SD == 1) asm volatile("s_waitcnt vmcnt(0)" ::: "memory"); else if constexpr (MLA) asm volatile("s_waitcnt vmcnt(3)" ::: "memory"); else asm volatile("s_waitcnt vmcnt(4)" ::: "memory"); } while (0)
#define RESC(a) do { if (__any((a) < 1.f)) { if (hi == 0) al_l[r32] = (a); asm volatile("s_waitcnt lgkmcnt(0)" ::: "memory"); \
    _Pragma("unroll") for (int d = 0; d < 4; ++d) _Pragma("unroll") for (int r = 0; r < 16; ++r) o[d][r] *= al_l[crow(r, hi)]; } } while (0)
    f32x16 pA0, pA1, pB0, pB1; float mnA, mnB, alA, alB; bf16x8 pa0, pa1, pa2, pa3; const int NT = seq / 64;
    constexpr int SE = 0, SO = SD - 1;
    SLOAD(SE, 0); asm volatile("s_waitcnt vmcnt(0)" ::: "memory"); SWRITE(0, SE); __syncthreads();
    qkt<MLA>(pA0, pA1, K_lds, KR_lds, qr, ql, r32, hi); partialSM<MLA>(pA0, pA1, m_reg, mnA, alA);
    SLOAD(SO, 64); if constexpr (SD == 2) { if (2 < NT) SLOAD(SE, 128); }
    SWAIT(); SWRITE(1, SO); __syncthreads();
    for (int j = 1; j + 1 < NT; j += 2) {
        SBAR(); qkt<MLA>(pB0, pB1, K_lds + SHM_K, KR_lds + SHM_KR, qr, ql, r32, hi);
        finishSM(pA0, pA1, alA, l_reg, pa0, pa1, pa2, pa3); SBAR();
        SLOAD(SO, (j + SD) * 64); SBAR();
        pv_d0(o, vb0, pa0, pa1, pa2, pa3); partialSM<MLA>(pB0, pB1, m_reg, mnB, alB);
        __syncthreads(); SWAIT(); SWRITE(0, SE);
        RESC(alB); __syncthreads();
        SBAR(); qkt<MLA>(pA0, pA1, K_lds, KR_lds, qr, ql, r32, hi);
        finishSM(pB0, pB1, alB, l_reg, pa0, pa1, pa2, pa3); SBAR();
        if (SD == 1 || j + 3 < NT) SLOAD(SE, (j + 1 + SD) * 64); SBAR();
        pv_d0(o, vb0 + SHM_V, pa0, pa1, pa2, pa3); partialSM<MLA>(pA0, pA1, m_reg, mnA, alA);
        __syncthreads(); SWAIT(); SWRITE(1, SO);
        RESC(alA); __syncthreads();
    }
    SBAR(); qkt<MLA>(pB0, pB1, K_lds + SHM_K, KR_lds + SHM_KR, qr, ql, r32, hi);
    finishSM(pA0, pA1, alA, l_reg, pa0, pa1, pa2, pa3); SBAR();
    pv_d0(o, vb0, pa0, pa1, pa2, pa3); partialSM<MLA>(pB0, pB1, m_reg, mnB, alB);
    __syncthreads(); RESC(alB);
    finishSM(pB0, pB1, alB, l_reg, pa0, pa1, pa2, pa3); SBAR();
    pv_d0(o, vb0 + SHM_V, pa0, pa1, pa2, pa3);
    if (hi == 0) li_l[r32] = l_reg; asm volatile("s_waitcnt lgkmcnt(0)" ::: "memory");
    float rli[16];
#pragma unroll
    for (int r = 0; r < 16; ++r) rli[r] = __builtin_amdgcn_rcpf(li_l[crow(r, hi)]);
    if (do_store) {
#pragma unroll
        for (int r = 0; r < 16; ++r) { const int orow = crow(r, hi);
#pragma unroll
            for (int d0 = 0; d0 < 4; ++d0) gst<bf16_t>(Ow + (size_t)orow * ldo + d0 * 32 + r32, f2bf(o[d0][r] * rli[r])); }
    }
    __syncthreads();
#undef SLOAD
#undef SWRITE
#undef SWAIT
#undef RESC
}


constexpr int TB3 = 40960, AL3_WS = 3 * TB3;
static_assert(AL3_WS + 2048 <= LDS_ST, "DMA attention ring overflows into the statistics");
__device__ __forceinline__ void qkt12(f32x16& p0, f32x16& p1, const char* Ks, const char* KRs, const bf16x8* qr, int r32, int hi) {
    p0 = f32x16{}; p1 = f32x16{};
#pragma unroll
    for (int d0 = 0; d0 < 8; ++d0) { const int cb = (d0 * 16 + hi * 8) * 2;
        const bf16x8 b0 = *reinterpret_cast<const bf16x8*>(Ks + KSWZ(r32, cb));
        const bf16x8 b1 = *reinterpret_cast<const bf16x8*>(Ks + KSWZ(32 + r32, cb));
        p0 = __builtin_amdgcn_mfma_f32_32x32x16_bf16(b0, qr[d0], p0, 0, 0, 0);
        p1 = __builtin_amdgcn_mfma_f32_32x32x16_bf16(b1, qr[d0], p1, 0, 0, 0); }
#pragma unroll
    for (int d0 = 0; d0 < 4; ++d0) { const int cb = (d0 * 16 + hi * 8) * 2;
        const bf16x8 b0 = *reinterpret_cast<const bf16x8*>(KRs + KRSWZ(r32, cb));
        const bf16x8 b1 = *reinterpret_cast<const bf16x8*>(KRs + KRSWZ(32 + r32, cb));
        p0 = __builtin_amdgcn_mfma_f32_32x32x16_bf16(b0, qr[8 + d0], p0, 0, 0, 0);
        p1 = __builtin_amdgcn_mfma_f32_32x32x16_bf16(b1, qr[8 + d0], p1, 0, 0, 0); }
}
template <bool MLA, int ldq, int ldk, int ldo>
__device__ __forceinline__ void attn_dma(const bf16_t* __restrict__ Qw, const bf16_t* __restrict__ Kg, const bf16_t* __restrict__ Vg, int seq, bf16_t* __restrict__ Ow, bool do_store, char* lds, const int tid) {
    constexpr int RB = ldk * 2, NQ = MLA ? 12 : 8;
    const int wid = __builtin_amdgcn_readfirstlane(tid >> 6), lane = tid & 63, r32 = lane & 31, hi = lane >> 5;
    float* ws = (float*)(lds + AL3_WS) + wid * 64; float* li_l = ws; float* al_l = ws + 32;
    float m_reg = -1e30f, l_reg = 0; f32x16 o[4] = {}; bf16x8 qr[NQ];
    const bf16_t* Ql = Qw + (size_t)r32 * ldq + hi * 8;
#pragma unroll
    for (int d0 = 0; d0 < NQ; ++d0) qr[d0] = gld<bf16x8>(Ql + d0 * 16);
    unsigned voffK, voffV, voffR;
    { const int G = wid * 64 + lane, row = G >> 4, sl = G & 15; voffK = (unsigned)(row * RB + ((sl ^ (row & 15)) * 16)); }
    { const int G = wid * 64 + lane, sub = G >> 5, r = G & 31, kk = (sub >> 2) * 8 + (r >> 2), k = (kk & ~0xC) | ((kk & 4) << 1) | ((kk & 8) >> 1), c = (sub & 3) * 32 + (r & 3) * 8;
      voffV = (unsigned)(k * RB + c * 2); }
    { const int G = wid * 64 + lane, row = G >> 3, sl = G & 7; voffR = (unsigned)(row * RB + 256 + ((sl ^ ((row >> 1) & 7)) * 16)); }
    const int vrd = v_rd_base(lane);
    LAS unsigned char* ldsl = (LAS unsigned char*)lds;
#define DMA3(boff, t) do { const char* _tb = (const char*)Kg + (size_t)(t) * (64 * RB); const char* _tv = MLA ? _tb : (const char*)Vg + (size_t)(t) * (64 * RB); LAS unsigned char* _lb = ldsl + (boff) + wid * 1024; \
        __builtin_amdgcn_global_load_lds((const unsigned*)(_tb + voffK), (LAS unsigned*)(_lb), 16, 0, 0); \
        __builtin_amdgcn_global_load_lds((const unsigned*)(_tb + 32 * RB + voffK), (LAS unsigned*)(_lb + 8192), 16, 0, 0); \
        __builtin_amdgcn_global_load_lds((const unsigned*)(_tv + voffV), (LAS unsigned*)(_lb + 16384), 16, 0, 0); \
        __builtin_amdgcn_global_load_lds((const unsigned*)(_tv + 32 * RB + voffV), (LAS unsigned*)(_lb + 24576), 16, 0, 0); \
        if constexpr (MLA) __builtin_amdgcn_global_load_lds((const unsigned*)(_tb + voffR), (LAS unsigned*)(_lb + 32768), 16, 0, 0); } while (0)
#define QKT3(P0, P1, boff) do { if constexpr (MLA) qkt12(P0, P1, lds + (boff), lds + (boff) + 32768, qr, r32, hi); else qkt<false>(P0, P1, lds + (boff), nullptr, qr, nullptr, r32, hi); } while (0)
#define RESC3(a) do { if (__any((a) < 1.f)) { if (hi == 0) al_l[r32] = (a); asm volatile("s_waitcnt lgkmcnt(0)" ::: "memory"); \
    _Pragma("unroll") for (int d = 0; d < 4; ++d) _Pragma("unroll") for (int r = 0; r < 16; ++r) o[d][r] *= al_l[crow(r, hi)]; } } while (0)
#define VB3(boff) ((int)(uintptr_t)(lds + (boff) + 16384) + vrd)
    f32x16 pA0, pA1, pB0, pB1; float mnA, mnB, alA, alB; bf16x8 pa0, pa1, pa2, pa3; const int NT = seq / 64;
    int bp = 0, bc = TB3, bn = 2 * TB3;
    DMA3(0, 0); DMA3(TB3, 1);
    asm volatile("s_waitcnt vmcnt(0)" ::: "memory"); __syncthreads();
    QKT3(pA0, pA1, 0); partialSM<MLA>(pA0, pA1, m_reg, mnA, alA);
    for (int j = 1; j + 1 < NT; j += 2) {
        DMA3(bn, j + 1);
        QKT3(pB0, pB1, bc);
        finishSM(pA0, pA1, alA, l_reg, pa0, pa1, pa2, pa3);
        pv_d0(o, VB3(bp), pa0, pa1, pa2, pa3); partialSM<MLA>(pB0, pB1, m_reg, mnB, alB);
        asm volatile("s_waitcnt vmcnt(0)" ::: "memory"); __syncthreads();
        RESC3(alB);
        { const int t_ = bp; bp = bc; bc = bn; bn = t_; }
        if (j + 2 < NT) DMA3(bn, j + 2);
        QKT3(pA0, pA1, bc);
        finishSM(pB0, pB1, alB, l_reg, pa0, pa1, pa2, pa3);
        pv_d0(o, VB3(bp), pa0, pa1, pa2, pa3); partialSM<MLA>(pA0, pA1, m_reg, mnA, alA);
        asm volatile("s_waitcnt vmcnt(0)" ::: "memory"); __syncthreads();
        RESC3(alA);
        { const int t_ = bp; bp = bc; bc = bn; bn = t_; }
    }
    SBAR(); QKT3(pB0, pB1, bc);
    finishSM(pA0, pA1, alA, l_reg, pa0, pa1, pa2, pa3); SBAR();
    pv_d0(o, VB3(bp), pa0, pa1, pa2, pa3); partialSM<MLA>(pB0, pB1, m_reg, mnB, alB);
    RESC3(alB);
    finishSM(pB0, pB1, alB, l_reg, pa0, pa1, pa2, pa3); SBAR();
    pv_d0(o, VB3(bc), pa0, pa1, pa2, pa3);
    if (hi == 0) li_l[r32] = l_reg; asm volatile("s_waitcnt lgkmcnt(0)" ::: "memory");
    float rli[16];
#pragma unroll
    for (int r = 0; r < 16; ++r) rli[r] = __builtin_amdgcn_rcpf(li_l[crow(r, hi)]);
    if (do_store) {
#pragma unroll
    for (int r = 0; r < 16; ++r) { const int orow = crow(r, hi);
#pragma unroll
        for (int d0 = 0; d0 < 4; ++d0) gst<bf16_t>(Ow + (size_t)orow * ldo + d0 * 32 + r32, f2bf(o[d0][r] * rli[r])); }
    }
    __syncthreads();
#undef QKT3
#undef DMA3
#undef RESC3
#undef VB3
}

enum { MAP_PLAIN = 0, MAP_FFN_IN, MAP_SGU_IN, MAP_MLA_IN };
__device__ __forceinline__ int map_col(int mode, int n0) {
    if (mode == MAP_FFN_IN) { const int pn = n0 >> 8, w = n0 & 255; return (w >> 7) * DFF + pn * 128 + (w & 127); }
    if (mode == MAP_SGU_IN) { return n0 < 1536 ? n0 : (n0 < 2048 ? 3072 + (n0 - 1536) : 1536 + (n0 - 2048)); }
    if (mode == MAP_MLA_IN) { return n0 < 448 ? n0 : (n0 < 512 ? -1 : 448 + (n0 - 512)); }
    return n0;
}
__device__ __forceinline__ int cvtT(const float* __restrict__ src, int sld, int K, int N, bf16_t* __restrict__ dst, const float* __restrict__ gain, float scale, int mode, float* tile, const int tid, int& tnext, int tbase) {
    const int ntk = K / 64, ntn = N / 256, tx = tid & 63, ty = tid >> 6;
    for (; tnext < tbase + ntk * ntn; tnext += NCU) {
        const int t = tnext - tbase, nb = t / ntk, kb = t % ntk; const int sc = map_col(mode, nb * 256 + (tx >> 4) * 64);
        __syncthreads();
        f32x4 v[8];
#pragma unroll
        for (int ps = 0; ps < 8; ++ps) { v[ps] = (f32x4){0.f, 0.f, 0.f, 0.f}; if (sc >= 0) v[ps] = gld<f32x4>(src + (size_t)(kb * 64 + ps * 8 + ty) * sld + sc + (tx & 15) * 4); }
#pragma unroll
        for (int ps = 0; ps < 8; ++ps) { const int kk = ps * 8 + ty; const float g = gain ? gld<float>(gain + kb * 64 + kk) * scale : scale; *(f32x4*)(tile + kk * 260 + tx * 4) = v[ps] * g; }
        __syncthreads();
#pragma unroll
        for (int q = 0; q < 4; ++q) {
            const int item = q * 512 + tid, n = item & 255, k8 = (item >> 8) * 8;
            u32x4 w;
            w[0] = cvtpk(tile[(k8 + 0) * 260 + n], tile[(k8 + 1) * 260 + n]); w[1] = cvtpk(tile[(k8 + 2) * 260 + n], tile[(k8 + 3) * 260 + n]);
            w[2] = cvtpk(tile[(k8 + 4) * 260 + n], tile[(k8 + 5) * 260 + n]); w[3] = cvtpk(tile[(k8 + 6) * 260 + n], tile[(k8 + 7) * 260 + n]);
            gst<u32x4>(dst + (size_t)(nb * 256 + n) * K + kb * 64 + k8, w);
        }
    }
    return tbase + ntk * ntn;
}

enum { OP_PREP = 0, OP_GSYNC, OP_G_MEMKV, OP_G_FFN1, OP_G_FFN2, OP_G_SGU_IN, OP_MIX, OP_MEMATT, OP_G_SGU_OUT, OP_G_MLA_IN, OP_KVPOST, OP_G_MLA_Q, OP_MLA_ATT, OP_G_MLA_OUT, OP_FINAL };
#define PC(op, l, sub) (unsigned char)((op) | ((l) << 4) | ((sub) << 6))
#define SGU_LAYER(l) PC(OP_G_FFN1, l, 0), PC(OP_G_FFN2, l, 0), PC(OP_G_SGU_IN, l, 0), PC(OP_MIX, l, 0), PC(OP_MEMATT, l, 0), PC(OP_G_SGU_OUT, l, 0), PC(OP_G_FFN1, l, 1), PC(OP_G_FFN2, l, 1)
#define MLA_LAYER(l) PC(OP_G_FFN1, l, 0), PC(OP_G_FFN2, l, 0), PC(OP_G_MLA_IN, l, 0), PC(OP_KVPOST, l, 0), PC(OP_G_MLA_Q, l, 0), PC(OP_GSYNC, l, 0), PC(OP_MLA_ATT, l, 0), PC(OP_MEMATT, l, 0), PC(OP_G_MLA_OUT, l, 0), PC(OP_G_FFN1, l, 1), PC(OP_G_FFN2, l, 1)
__constant__ double ROPEC[17] = { 1.333521432163324, 0.6366197723675814, 1.5707963267948966, 6.123233995736766e-17,
    -1.0 / 6, 1.0 / 120, -1.0 / 5040, 1.0 / 362880, -1.0 / 39916800, 1.0 / 6227020800.0,
    -0.5, 1.0 / 24, -1.0 / 720, 1.0 / 40320, -1.0 / 3628800, 1.0 / 479001600.0, -1.0 / 87178291200.0 };
constexpr int NPROG = 46;
__constant__ unsigned char PROG[NPROG] = {
    PC(OP_PREP, 0, 0), PC(OP_GSYNC, 0, 0), PC(OP_G_MEMKV, 0, 0), PC(OP_GSYNC, 0, 0),
    SGU_LAYER(0), MLA_LAYER(1),
    PC(OP_GSYNC, 0, 0), PC(OP_PREP, 2, 0), PC(OP_GSYNC, 0, 0),
    SGU_LAYER(2), MLA_LAYER(3),
    PC(OP_FINAL, 0, 0) };

__global__ __launch_bounds__(512, 2) void fwd_megakernel(Params p) {
    extern __shared__ __attribute__((aligned(16))) unsigned char shm[];
    cg::grid_group grid = cg::this_grid();
    const int cu = blockIdx.x;
    LAS unsigned char* lds = (LAS unsigned char*)shm;
    float* st = (float*)(shm + LDS_ST);
    float* st_rsx = st, *st_rv = st + 256, *st_rq = st + 512, *st_xacc = st + 1024, *st_vacc = st + 2048, *st_qacc = st + 3072;
    float* tile = (float*)shm;
    const float** tab = (const float**)(shm + LDS_TAB);
    if (threadIdx.x < 26) tab[threadIdx.x] = p.in[threadIdx.x];
    __syncthreads();
#define PIN(i) as_global(((const float* volatile*)tab)[i])
    grid.sync();
    int nsync = 0;
    for (int pc = 0; pc < NPROG; ++pc) {
        int tid = threadIdx.x; asm volatile("" : "+v"(tid));
        const int wid = tid >> 6, lane = tid & 63;
        unsigned char* ws = p.ws; float* outp = p.out; asm volatile("" : "+s"(ws), "+s"(outp)); ws = as_global(ws); outp = as_global(outp);
        bf16_t* X = (bf16_t*)outp;
        unsigned char* slab = ws + WS_SCR + (size_t)cu * SLAB;
        bf16_t* HID = (bf16_t*)(slab + SCR_HID);
        bf16_t* Pb = (bf16_t*)(slab + SCR_P);
        bf16_t* VT = (bf16_t*)(slab + SCR_VT);
        bf16_t* QF = (bf16_t*)(slab + SCR_QF);
        bf16_t* C2 = (bf16_t*)(slab + SCR_C2);
        bf16_t* KB = (bf16_t*)(ws + WS_KBUF);
        bf16_t* MEMKV = (bf16_t*)(ws + WS_MEMKV);
        float* kvraw = (float*)(C2 + 256);
        const float* rcos = (const float*)(ws + WS_ROPE); const float* rsin = rcos + 16384 * 32;
        const size_t hstepTok = (size_t)TPROMPT * 2;
        const size_t hstepLoc = (size_t)128 * 2;

#ifdef RUN_UNTIL
        if (pc >= RUN_UNTIL && pc != NPROG - 1) continue;
#endif
        const int code = PROG[pc], op = code & 15, l = (code >> 4) & 3, sub = (code >> 6) & 1, dup = code >> 7, j = l >> 1;
        unsigned char* slot = ws + ((l & 1) ? WS_SLOTB : WS_SLOTA);
        const bool is_gemm = (op == OP_G_MEMKV || op == OP_G_FFN1 || op == OP_G_FFN2 || op == OP_G_SGU_IN || op == OP_G_SGU_OUT || op == OP_G_MLA_IN || op == OP_G_MLA_Q || op == OP_G_MLA_OUT);
        if (is_gemm) {
            GemmArgs g{}; Epi e{}; e.cu = cu; e.ws = ws; e.out = outp; e.st = st; e.alpha = 1.f; bool run = true;
            if (op == OP_G_MEMKV) {
                run = cu < 96; const int ll = cu / 24, rem = cu % 24, rb = rem >> 2, pn = rem & 3;
                g.A = (const bf16_t*)(ws + WS_MEMN) + (size_t)rb * 256 * 1024; g.hstepA = (size_t)128 * 1024 * 2; g.lda = 1024;
                g.Bt = (const bf16_t*)(ws + WS_MEMW) + ((size_t)ll * 1024 + pn * 256) * 1024; g.K = 1024; g.nN = 1;
                e.mode = EP_MEMKV;
            } else if (op == OP_G_FFN1) {
                g.A = X + (size_t)cu * 128 * XLD; g.hstepA = hstepTok * XLD; g.lda = XLD; g.Bt = (const bf16_t*)(slot + (sub == 0 ? SL_F1I : SL_F2I)); g.K = 1024; g.nN = 22;
                e.mode = EP_FFN1;
            } else if (op == OP_G_FFN2) {
                g.A = HID; g.hstepA = hstepLoc * HID_LD; g.lda = HID_LD; g.Bt = (const bf16_t*)(slot + (sub == 0 ? SL_F1O : SL_F2O)); g.K = 2816; g.nN = 4;
                e.mode = EP_XUPD; e.alpha = dup ? 0.f : 0.5f;
            } else if (op == OP_G_SGU_IN) {
                g.A = X + (size_t)cu * 128 * XLD; g.hstepA = hstepTok * XLD; g.lda = XLD; g.Bt = (const bf16_t*)(slot + SG_IN); g.K = 1024; g.nN = 14;
                e.mode = EP_SGU_IN;
                if (tid < 256) { st_vacc[tid] = 0.f; st_vacc[256 + tid] = 0.f; st_vacc[512 + tid] = 0.f; st_vacc[768 + tid] = 0.f; }
            } else if (op == OP_G_SGU_OUT) {
                g.A = Pb; g.hstepA = hstepLoc * P_LD; g.lda = P_LD; g.Bt = (const bf16_t*)(slot + SG_OUT); g.K = 2048; g.nN = 4;
                e.mode = EP_XUPD; e.alpha = 1.0f;
            } else if (op == OP_G_MLA_IN) {
                g.A = X + (size_t)cu * 128 * XLD; g.hstepA = hstepTok * XLD; g.lda = XLD; g.Bt = (const bf16_t*)(slot + ML_IN); g.K = 1024; g.nN = 4;
                e.mode = EP_MLA_IN;
                if (tid < 256) { st_qacc[tid] = 0.f; st_qacc[256 + tid] = 0.f; st_qacc[512 + tid] = 0.f; st_qacc[768 + tid] = 0.f; }
            } else if (op == OP_G_MLA_Q) {
                g.A = C2; g.hstepA = hstepLoc * C2_LD; g.lda = C2_LD; g.Bt = (const bf16_t*)(slot + ML_Q); g.K = 256; g.nN = 6;
                e.mode = EP_MLA_Q;
            } else {
                g.A = C2; g.hstepA = hstepLoc * C2_LD; g.lda = C2_LD; g.Bt = (const bf16_t*)(slot + ML_OUT); g.K = 1536; g.nN = 4;
                e.mode = EP_XUPD; e.alpha = 1.0f;
            }
            __syncthreads();
            if (run) gemm_phase(lds, g, e, tid);
            if (tid < 256) {
                if (e.mode == EP_XUPD) { st_rsx[tid] = rsqrtf(((st_xacc[tid] + st_xacc[256 + tid]) + (st_xacc[512 + tid] + st_xacc[768 + tid])) * (1.f / 1024.f) + EPS); st_xacc[tid] = 0.f; st_xacc[256 + tid] = 0.f; st_xacc[512 + tid] = 0.f; st_xacc[768 + tid] = 0.f; }
                else if (e.mode == EP_SGU_IN) st_rv[tid] = rsqrtf(((st_vacc[tid] + st_vacc[256 + tid]) + (st_vacc[512 + tid] + st_vacc[768 + tid])) * (1.f / 1536.f) + EPS);
                else if (e.mode == EP_MLA_IN) st_rq[tid] = rsqrtf(((st_qacc[tid] + st_qacc[256 + tid]) + (st_qacc[512 + tid] + st_qacc[768 + tid])) * (1.f / 256.f) + EPS);
            }
            __syncthreads();
        } else if (op == OP_GSYNC) {
            asm volatile("s_waitcnt vmcnt(0) lgkmcnt(0)" ::: "memory");
            __syncthreads();
            ++nsync;
            if (wid == 0) {
                __builtin_amdgcn_fence(__ATOMIC_RELEASE, "agent"); asm volatile("s_waitcnt vmcnt(0) lgkmcnt(0)" ::: "memory");
                if (tid == 0) {
                    unsigned* bar = (unsigned*)(ws + WS_BAR);
                    __hip_atomic_fetch_add(bar, 1u, __ATOMIC_RELAXED, __HIP_MEMORY_SCOPE_AGENT);
                    while (__hip_atomic_load(bar, __ATOMIC_RELAXED, __HIP_MEMORY_SCOPE_AGENT) < (unsigned)(NCU * nsync)) __builtin_amdgcn_s_sleep(4);
                }
                __builtin_amdgcn_fence(__ATOMIC_ACQUIRE, "agent"); asm volatile("s_waitcnt vmcnt(0) lgkmcnt(0)" ::: "memory");
            }
            __syncthreads();
        } else if (op == OP_PREP) {
            const int nitems = (l == 0) ? 16 : 12; int tnext = cu, tbase = 0;
            for (int item = 0; item < nitems; ++item) {
                const float* src; int sld, K, N, mode = MAP_PLAIN; bf16_t* dst; const float* gain = nullptr; bool skip = false;
                if (item < 12) {
                    const int ll = l + item / 6, m = item % 6; unsigned char* sl = ws + ((ll & 1) ? WS_SLOTB : WS_SLOTA); const int jj = ll >> 1;
                    if (m == 0 || m == 2) { src = PIN(m == 0 ? 5 : 11) + (size_t)ll * 1024 * 5632; sld = 5632; K = 1024; N = 5632; dst = (bf16_t*)(sl + (m == 0 ? SL_F1I : SL_F2I)); gain = PIN(m == 0 ? 4 : 10) + ll * 1024; mode = MAP_FFN_IN; }
                    else if (m == 1 || m == 3) { src = PIN(m == 1 ? 6 : 12) + (size_t)ll * 2816 * 1024; sld = 1024; K = 2816; N = 1024; dst = (bf16_t*)(sl + (m == 1 ? SL_F1O : SL_F2O)); }
                    else if (m == 4) {
                        if ((ll & 1) == 0) { src = PIN(13) + (size_t)jj * 1024 * 3584; sld = 3584; K = 1024; N = 3584; dst = (bf16_t*)(sl + SG_IN); gain = PIN(7) + ll * 1024; mode = MAP_SGU_IN; }
                        else { src = PIN(18) + (size_t)jj * 1024 * 960; sld = 960; K = 1024; N = 1024; dst = (bf16_t*)(sl + ML_IN); gain = PIN(7) + ll * 1024; mode = MAP_MLA_IN; }
                    } else {
                        if ((ll & 1) == 0) { src = PIN(17) + (size_t)jj * 2048 * 1024; sld = 1024; K = 2048; N = 1024; dst = (bf16_t*)(sl + SG_OUT); }
                        else { skip = true; src = nullptr; sld = K = N = 64; dst = nullptr; }
                    }
                } else { const int ll = item - 12; src = PIN(9) + (size_t)ll * 1024 * 1024; sld = 1024; K = 1024; N = 1024; dst = (bf16_t*)(ws + WS_MEMW) + (size_t)ll * 1024 * 1024; gain = PIN(8) + ll * 1024; }
                if (!skip) tbase = cvtT(src, sld, K, N, dst, gain, 1.f, mode, tile, tid, tnext, tbase);
            }
            __syncthreads();
            const size_t gt = (size_t)cu * NTHR + tid, gn = (size_t)NCU * NTHR;
            {
                const int jj = l >> 1; const float* wsp = PIN(15) + (size_t)jj * 8 * 128 * 128; bf16_t* d = (bf16_t*)(ws + WS_SLOTA + SG_WS);
                for (size_t i = gt; i < (size_t)8 * 128 * 128; i += gn) d[i] = f2bf(wsp[i]);
            }
            {
                const int jj = l >> 1; unsigned char* sl = ws + WS_SLOTB;
                const float* wuq = PIN(20) + (size_t)jj * 256 * 1536; const float* wuk = PIN(22) + (size_t)jj * 128 * 8 * 128; const float* qn = PIN(19) + jj * 256;
                bf16_t* dq = (bf16_t*)(sl + ML_Q); const float qs = 0.07216878364870322f;
                for (size_t i = gt; i < (size_t)1536 * 256; i += gn) {
                    const int n = (int)(i >> 8), k = (int)(i & 255); float v;
                    if (n < 1024) { const int h = n >> 7, c = n & 127; const float* a = wuq + (size_t)k * 1536 + h * 192; const float* b = wuk + ((size_t)c * 8 + h) * 128; float sacc = 0.f;
                        for (int d = 0; d < 128; d += 4) { const f32x4 x = *(const f32x4*)(a + d), y = *(const f32x4*)(b + d); sacc += x[0] * y[0] + x[1] * y[1] + x[2] * y[2] + x[3] * y[3]; } v = sacc; }
                    else { const int rem = n - 1024, t = rem >> 8, w = rem & 255, half = w >> 7, hh = (w & 127) >> 5, j2 = w & 31; v = wuq[(size_t)k * 1536 + (4 * t + hh) * 192 + 128 + 32 * half + j2]; }
                    dq[i] = f2bf(v * qn[k] * qs);
                }
                const float* wuv = PIN(23) + (size_t)jj * 128 * 8 * 128; const float* wo = PIN(24) + (size_t)jj * 1536 * 1024; bf16_t* dout = (bf16_t*)(sl + ML_OUT);
                for (size_t i = gt; i < (size_t)8 * 64 * 256; i += gn) {
                    const int n = (int)(i & 255) * 4, c = (int)((i >> 8) & 63) * 2, h = (int)(i >> 14);
                    const float* a0 = wuv + ((size_t)c * 8 + h) * 128; const float* a1 = a0 + 8 * 128; const float* b = wo + (size_t)(h * 128) * 1024 + n;
                    f32x4 s0 = {0.f, 0.f, 0.f, 0.f}, s1 = {0.f, 0.f, 0.f, 0.f};
#pragma unroll 8
                    for (int d = 0; d < 128; ++d) { const f32x4 bv = *(const f32x4*)(b + (size_t)d * 1024); s0 += bv * a0[d]; s1 += bv * a1[d]; }
                    const int kk = h * 128 + c;
#pragma unroll
                    for (int q = 0; q < 4; ++q) *(unsigned*)(dout + (size_t)(n + q) * 1536 + kk) = cvtpk(s0[q], s1[q]);
                }
                for (size_t i = gt; i < (size_t)512 * 256; i += gn) {
                    const int kk = 1024 + (int)(i >> 8), n = (int)(i & 255) * 4; const f32x4 v = *(const f32x4*)(wo + (size_t)kk * 1024 + n);
#pragma unroll
                    for (int q = 0; q < 4; ++q) dout[(size_t)(n + q) * 1536 + kk] = f2bf(v[q]);
                }
            }
            if (l == 0) {
                {
                    bf16_t* memn = (bf16_t*)(ws + WS_MEMN);
                    for (int r = cu * 8 + wid; r < 1536; r += NCU * 8) {
                        const float* src = r < 1024 ? PIN(2) + (size_t)r * 1024 : PIN(3) + (size_t)(r - 1024) * 1024;
                        f32x4 v[4]; float ss = 0.f;
#pragma unroll
                        for (int q = 0; q < 4; ++q) { v[q] = *(const f32x4*)(src + q * 256 + lane * 4); ss += v[q][0] * v[q][0] + v[q][1] * v[q][1] + v[q][2] * v[q][2] + v[q][3] * v[q][3]; }
                        ss = wave_sum(ss); const float rs = rsqrtf(ss * (1.f / 1024.f) + EPS);
#pragma unroll
                        for (int q = 0; q < 4; ++q) { u32x2 w; w[0] = cvtpk(v[q][0] * rs, v[q][1] * rs); w[1] = cvtpk(v[q][2] * rs, v[q][3] * rs); *(u32x2*)(memn + (size_t)r * 1024 + q * 256 + lane * 4) = w; }
                    }
                }
                {
                    float* c = (float*)(ws + WS_ROPE); float* s = c + 16384 * 32;
                    for (int i = cu * NTHR + tid; i < 16384 * 32; i += NCU * NTHR) {
                        const int pos = i >> 5, jj = i & 31;
                        const volatile double* rc = ROPEC;
                        const double cB = rc[0];
                        double bp = 1.0; for (int t = 0; t < jj; ++t) bp *= cB;
                        const float invf = 1.0f / (float)bp;
                        const float ang = (float)pos * invf;
                        const double ad = (double)ang, kq = rint(ad * rc[1]);
                        const double r = (ad - kq * rc[2]) - kq * rc[3], r2 = r * r;
                        const double sr = r * (1.0 + r2 * (rc[4] + r2 * (rc[5] + r2 * (rc[6] + r2 * (rc[7] + r2 * (rc[8] + r2 * rc[9]))))));
                        const double cr = 1.0 + r2 * (rc[10] + r2 * (rc[11] + r2 * (rc[12] + r2 * (rc[13] + r2 * (rc[14] + r2 * (rc[15] + r2 * rc[16]))))));
                        const int qd = ((int)kq) & 3;
                        const double sd = (qd == 0) ? sr : (qd == 1) ? cr : (qd == 2) ? -sr : -cr;
                        const double cd = (qd == 0) ? cr : (qd == 1) ? -sr : (qd == 2) ? -cr : sr;
                        c[i] = (float)cd; s[i] = (float)sd;
                    }
                }
                {
                    const float* xin0 = PIN(0); const float* xin1 = PIN(1);
                    for (int it = 0; it < 8; ++it) {
                        f32x4 v[4][4];
#pragma unroll
                        for (int u = 0; u < 4; ++u) { const int rr = wid + 8 * (4 * it + u), ai = rr >> 7, pr = rr & 127; const float* src = (ai ? xin1 : xin0) + ((size_t)cu * 128 + pr) * 1024;
#pragma unroll
                            for (int q = 0; q < 4; ++q) v[u][q] = gld<f32x4>(src + q * 256 + lane * 4); }
#pragma unroll
                        for (int u = 0; u < 4; ++u) { const int rr = wid + 8 * (4 * it + u), ai = rr >> 7, pr = rr & 127;
                            bf16_t* dst = X + ((size_t)ai * TPROMPT + (size_t)cu * 128 + pr) * XLD; float ss = 0.f;
#pragma unroll
                            for (int q = 0; q < 4; ++q) ss += v[u][q][0] * v[u][q][0] + v[u][q][1] * v[u][q][1] + v[u][q][2] * v[u][q][2] + v[u][q][3] * v[u][q][3];
                            ss = wave_sum(ss);
#pragma unroll
                            for (int q = 0; q < 4; ++q) {
                                u32x2 h, lo; h[0] = cvtpk(v[u][q][0], v[u][q][1]); h[1] = cvtpk(v[u][q][2], v[u][q][3]);
                                gst<u32x2>(dst + q * 256 + lane * 4, h);
                                if (XLO) { lo[0] = cvtpk(v[u][q][0] - bflo(h[0]), v[u][q][1] - bfhi(h[0])); lo[1] = cvtpk(v[u][q][2] - bflo(h[1]), v[u][q][3] - bfhi(h[1])); gst<u32x2>(dst + 1024 + q * 256 + lane * 4, lo); }
                            }
                            if (lane == 0) st_rsx[rr] = rsqrtf(ss * (1.f / 1024.f) + EPS);
                        }
                    }
                    if (tid < 256) { st_xacc[tid] = 0.f; st_xacc[256 + tid] = 0.f; st_xacc[512 + tid] = 0.f; st_xacc[768 + tid] = 0.f; }
                }
            }
        } else if (op == OP_MIX) {
#ifndef NO_MIX
            const int gi = wid, fr = lane & 15, fq = lane >> 4;
            const bf16_t* Wsg = (const bf16_t*)(slot + SG_WS) + (size_t)gi * 128 * 128;
            const float* vgain = PIN(14) + j * 1536 + gi * 192; const float* bs = PIN(16) + (size_t)j * 8 * 128 + gi * 128;
            for (int ai = 0; ai < 2; ++ai) {
                bf16x8 bw[8][4];
#pragma unroll
                for (int ks = 0; ks < 4; ++ks) {
                    float rv8[8];
#pragma unroll
                    for (int i = 0; i < 8; ++i) rv8[i] = st_rv[ai * 128 + ks * 32 + fq * 8 + i];
#pragma unroll
                    for (int pb = 0; pb < 8; ++pb) {
                        const u32x4 raw = gld<u32x4>(Wsg + (size_t)(pb * 16 + fr) * 128 + ks * 32 + fq * 8);
                        u32x4 w;
#pragma unroll
                        for (int i = 0; i < 4; ++i) w[i] = cvtpk(bflo(raw[i]) * rv8[2 * i], bfhi(raw[i]) * rv8[2 * i + 1]);
                        bw[pb][ks] = *reinterpret_cast<bf16x8*>(&w);
                    }
                    __builtin_amdgcn_sched_barrier(0);
                }
                const bf16_t* vtg = VT + ((size_t)ai * 1536 + gi * 192) * 128;
                bf16_t* const ubase = Pb + (size_t)(ai * 128 + fr) * P_LD + gi * 192 + fq * 4;
                for (int cb = 0; cb < 12; ++cb) {
                    bf16x8 af[4];
#pragma unroll
                    for (int ks = 0; ks < 4; ++ks) af[ks] = gld<bf16x8>(vtg + (size_t)(cb * 16 + fr) * 128 + ks * 32 + fq * 8);
                    const f32x4 gn = gld<f32x4>(vgain + cb * 16 + fq * 4);
#pragma unroll
                    for (int ph = 0; ph < 2; ++ph) {
                        u32x2 uw[4];
#pragma unroll
                        for (int pb = 0; pb < 4; ++pb) uw[pb] = gld<u32x2>(ubase + (size_t)((ph * 4 + pb) * 16) * P_LD + cb * 16);
#pragma unroll
                        for (int pb = 0; pb < 4; ++pb) {
                            f32x4 d = {0.f, 0.f, 0.f, 0.f};
#pragma unroll
                            for (int ks = 0; ks < 4; ++ks) d = __builtin_amdgcn_mfma_f32_16x16x32_bf16(af[ks], bw[ph * 4 + pb][ks], d, 0, 0, 0);
                            const float bbv = gld<float>(bs + (ph * 4 + pb) * 16 + fr);
                            u32x2 w; w[0] = cvtpk(bflo(uw[pb][0]) * (gn[0] * d[0] + bbv), bfhi(uw[pb][0]) * (gn[1] * d[1] + bbv));
                            w[1] = cvtpk(bflo(uw[pb][1]) * (gn[2] * d[2] + bbv), bfhi(uw[pb][1]) * (gn[3] * d[3] + bbv));
                            gst<u32x2>(ubase + (size_t)((ph * 4 + pb) * 16) * P_LD + cb * 16, w);
                        }
                        __builtin_amdgcn_sched_barrier(0);
                    }
                }
            }
            __syncthreads();
#endif
        } else if (op == OP_MEMATT) {
#ifndef NO_MEMATT
            static_assert(P_LD == C2_LD, "one row stride for both concat buffers"); bf16_t* buf = (l & 1) ? C2 : Pb; constexpr int ld = P_LD; const int qoff = (l & 1) ? 1024 : 1536;
            for (int it = 0; it < 8; ++it) {
                int t2 = tid; asm volatile("" : "+v"(t2)); const int wid = t2 >> 6;
                const int ai = it >> 2, h = it & 3; const int mb = ai ? 4 + (cu >> 7) : (cu >> 6);
                const bf16_t* kg = MEMKV + ((size_t)l * 1536 + mb * 256) * 1024 + h * 128;
                bf16_t* q = buf + (size_t)(ai * 128 + (wid & 3) * 32) * ld + qoff + h * 128;
                #if MLA_DMA
                attn_dma<false, P_LD, 1024, P_LD>(q, kg, kg + 512, 256, q, wid < 4, (char*)shm, t2);
#else
                attn_body<false, P_LD, 1024, P_LD>(q, kg, kg + 512, 256, q, wid < 4, (char*)shm, t2);
#endif
            }
#endif
        } else if (op == OP_KVPOST) {
            const float* kvg = PIN(21) + j * 128;
            const float g0 = gld<float>(kvg + lane * 2), g1 = gld<float>(kvg + lane * 2 + 1);
            for (int it = 0; it < 8; ++it) {
                float a0[4], a1[4], x1[4], x2[4], cc[4], sn[4];
#pragma unroll
                for (int u = 0; u < 4; ++u) { const int rr = wid + 8 * (4 * it + u), ai = rr >> 7, pr = rr & 127; const float* src = kvraw + (size_t)rr * (C2_LD / 2);
                    const int pos = (cu * 128 + pr) & (ai ? 16383 : 8191), l32 = lane & 31;
                    a0[u] = gld<float>(src + lane * 2); a1[u] = gld<float>(src + lane * 2 + 1);
                    x1[u] = gld<float>(src + 128 + l32); x2[u] = gld<float>(src + 160 + l32); cc[u] = gld<float>(rcos + pos * 32 + l32); sn[u] = gld<float>(rsin + pos * 32 + l32); }
#pragma unroll
                for (int u = 0; u < 4; ++u) { const int rr = wid + 8 * (4 * it + u), ai = rr >> 7, pr = rr & 127; const size_t g = (size_t)ai * TPROMPT + (size_t)cu * 128 + pr;
                    const float ss = wave_sum(a0[u] * a0[u] + a1[u] * a1[u]); const float rs = rsqrtf(ss * (1.f / 128.f) + EPS);
                    bf16_t* kd = KB + g * K_LD;
                    gst<unsigned>(kd + lane * 2, cvtpk(a0[u] * rs * g0, a1[u] * rs * g1));
                    if (lane < 32) { gst<bf16_t>(kd + 128 + lane, f2bf(x1[u] * cc[u] - x2[u] * sn[u])); gst<bf16_t>(kd + 160 + lane, f2bf(x1[u] * sn[u] + x2[u] * cc[u])); }
                }
            }
            __syncthreads();
        } else if (op == OP_MLA_ATT) {
#ifndef NO_MLAATT
            for (int it = 0; it < 8; ++it) {
                int t2 = tid; asm volatile("" : "+v"(t2)); const int wid = t2 >> 6;
                const int ai = it >> 2, hp = it & 3; const int seq = ai ? 16384 : 8192;
                const size_t g0 = (size_t)ai * TPROMPT + (size_t)cu * 128;
                const size_t s0 = (size_t)ai * TPROMPT + ((size_t)cu * 128 / seq) * seq;
                const int head = 2 * hp + (wid >> 2);
                const size_t lrow0 = (size_t)(ai * 128 + (wid & 3) * 32);
                #if MLA_DMA
                attn_dma<true, QF_LD, K_LD, C2_LD>(QF + lrow0 * QF_LD + head * 192, KB + s0 * K_LD, nullptr, seq, C2 + lrow0 * C2_LD + head * 128, true, (char*)shm, t2);
#else
                attn_body<true, QF_LD, K_LD, C2_LD>(QF + lrow0 * QF_LD + head * 192, KB + s0 * K_LD, nullptr, seq, C2 + lrow0 * C2_LD + head * 128, true, (char*)shm, t2);
#endif
            }
#endif
        } else {
            const float* fg = PIN(25);
            f32x4 gq[4];
#pragma unroll
            for (int q = 0; q < 4; ++q) gq[q] = gld<f32x4>(fg + q * 256 + lane * 4);
            for (int it = 0; it < 8; ++it) {
                u32x2 h[4][4], lo[4][4];
#pragma unroll
                for (int u = 0; u < 4; ++u) { const int rr = wid + 8 * (4 * it + u), ai = rr >> 7, pr = rr & 127; const bf16_t* row = X + ((size_t)ai * TPROMPT + (size_t)cu * 128 + pr) * XLD;
#pragma unroll
                    for (int q = 0; q < 4; ++q) { h[u][q] = gld<u32x2>(row + q * 256 + lane * 4); lo[u][q] = (u32x2){0u, 0u}; if (XLO) lo[u][q] = gld<u32x2>(row + 1024 + q * 256 + lane * 4); } }
                asm volatile("s_waitcnt vmcnt(0)" ::: "memory");
#pragma unroll
                for (int u = 0; u < 4; ++u) { const int rr = wid + 8 * (4 * it + u), ai = rr >> 7, pr = rr & 127; float* orow = (float*)(X + ((size_t)ai * TPROMPT + (size_t)cu * 128 + pr) * XLD); const float rs = st_rsx[rr];
#pragma unroll
                    for (int q = 0; q < 4; ++q) {
                        f32x4 y; y[0] = (bflo(h[u][q][0]) + bflo(lo[u][q][0])) * rs * gq[q][0]; y[1] = (bfhi(h[u][q][0]) + bfhi(lo[u][q][0])) * rs * gq[q][1];
                        y[2] = (bflo(h[u][q][1]) + bflo(lo[u][q][1])) * rs * gq[q][2]; y[3] = (bfhi(h[u][q][1]) + bfhi(lo[u][q][1])) * rs * gq[q][3];
                        gst<f32x4>(orow + q * 256 + lane * 4, y);
                    }
                }
            }
        }
    }
}

extern "C" void kernel_launch(void* const* d_in, const int* in_sizes, int n_in, void* d_out, int out_size, void* d_ws, size_t ws_size, hipStream_t stream) {
    static int ready = 0;
    if (ready == 0) {
        if (n_in != 26 || out_size != NTOK * DM || ws_size < WS_END) { fprintf(stderr, "kernel_launch: unexpected shapes (n_in %d out %d ws %zu need %zu)\n", n_in, out_size, ws_size, (size_t)WS_END); ready = -1; return; }
        if (hipFuncSetAttribute((const void*)fwd_megakernel, hipFuncAttributeMaxDynamicSharedMemorySize, LDS_TOTAL) != hipSuccess) { fprintf(stderr, "kernel_launch: hipFuncSetAttribute failed\n"); ready = -1; return; }
        int per_cu = 0; (void)hipOccupancyMaxActiveBlocksPerMultiprocessor(&per_cu, (const void*)fwd_megakernel, NTHR, LDS_TOTAL); (void)hipGetLastError();
        ready = 1;
    }
    if (ready < 0) return;
    Params p{};
    for (int i = 0; i < 26; ++i) p.in[i] = (const float*)d_in[i];
    p.out = (float*)d_out; p.ws = (unsigned char*)d_ws;
    if (hipMemsetAsync((unsigned char*)d_ws + WS_BAR, 0, 256, stream) != hipSuccess) { fprintf(stderr, "kernel_launch: memset of the barrier word failed\n"); return; }
    void* args[] = {&p};
    hipError_t e = hipLaunchCooperativeKernel((const void*)fwd_megakernel, dim3(NCU), dim3(NTHR), args, LDS_TOTAL, stream);
    if (e != hipSuccess) fprintf(stderr, "kernel_launch: cooperative launch failed: %s\n", hipGetErrorString(e));
}
```
